# Optimizing an MI355X kernel written in HIP

```python
import jax, jax.numpy as jnp
from jax import lax
import numpy as np

D_MODEL = 1024
BATCH = 8
SEQ = 2048
DEPTH = 2

CHUNK = 64
HEAD_DIM = 64
N_HEADS_SB = 4
N_HEADS_CH = 8
N_HEADS_FOX = 4
W_SB = N_HEADS_SB * HEAD_DIM
W_CH = N_HEADS_CH * HEAD_DIM
W_FOX = N_HEADS_FOX * HEAD_DIM
LEFT_CHUNKS = 8
BAND = (LEFT_CHUNKS + 1) * CHUNK
MAX_REL = 128
N_REL = 2 * MAX_REL + 1
Q_BLOCK = 128
N_BRANCH = 3
D_FF = ((8 * D_MODEL // 3 + 127) // 128) * 128
QKV_WIDTH = 3 * (W_SB + W_CH + W_FOX)
FORGET_OFFSET = QKV_WIDTH
IN_WIDTH = QKV_WIDTH + N_HEADS_FOX + N_BRANCH * D_MODEL
SPLIT_SIZES = (W_SB, W_SB, W_SB, W_CH, W_CH, W_CH, W_FOX, W_FOX, W_FOX, N_HEADS_FOX, D_MODEL, D_MODEL, D_MODEL)
SPLIT_POINTS = tuple(int(v) for v in np.cumsum(SPLIT_SIZES)[:-1])
FORGET_BIAS_INIT = 4.0
RMS_EPS = 1e-6
NEG = -1e30

kernel_name = "hybrid_stickbreak_chunkrel_fox_macaron"


def rmsnorm(x, g):
    xf = x.astype(jnp.float32)
    y = xf * lax.rsqrt(jnp.mean(xf * xf, axis=-1, keepdims=True) + RMS_EPS)
    return (y * g.astype(jnp.float32)).astype(x.dtype)


def swiglu(h, w_in, w_out):
    gate, up = jnp.split(h @ w_in, 2, axis=-1)
    return (jax.nn.silu(gate) * up) @ w_out


def split_heads(t, n_heads):
    b, s, _ = t.shape
    return t.reshape(b, s, n_heads, HEAD_DIM).transpose(0, 2, 1, 3)


def merge_heads(t):
    b, h, s, d = t.shape
    return t.transpose(0, 2, 1, 3).reshape(b, s, h * d)


def stick_breaking_attention(q, k, v):
    T = q.shape[2]
    scale = HEAD_DIM ** -0.5
    outs = []
    for start in range(0, T, Q_BLOCK):
        end = start + Q_BLOCK
        z = jnp.einsum('bhqd,bhkd->bhqk', q[:, :, start:end], k[:, :, :end]).astype(jnp.float32) * scale
        strict = jnp.arange(end)[None, :] < jnp.arange(start, end)[:, None]
        log_beta = jax.nn.log_sigmoid(z)
        log_fail = jnp.where(strict, jax.nn.log_sigmoid(-z), 0.0)
        between = lax.cumsum(log_fail, axis=3, reverse=True) - log_fail
        w = jnp.where(strict, jnp.exp(log_beta + between), 0.0)
        outs.append(jnp.einsum('bhqk,bhkd->bhqd', w.astype(v.dtype), v[:, :, :end]))
    return jnp.concatenate(outs, axis=2)


def forgetting_attention(q, k, v, log_f):
    T = q.shape[2]
    scale = HEAD_DIM ** -0.5
    F = jnp.cumsum(log_f, axis=-1)
    outs = []
    for start in range(0, T, Q_BLOCK):
        end = start + Q_BLOCK
        z = jnp.einsum('bhqd,bhkd->bhqk', q[:, :, start:end], k[:, :, :end]).astype(jnp.float32) * scale
        z = z + F[:, :, start:end, None] - F[:, :, None, :end]
        causal = jnp.arange(end)[None, :] <= jnp.arange(start, end)[:, None]
        p = jax.nn.softmax(jnp.where(causal, z, NEG), axis=-1)
        outs.append(jnp.einsum('bhqk,bhkd->bhqd', p.astype(v.dtype), v[:, :, :end]))
    return jnp.concatenate(outs, axis=2)


def chunked_relpos_attention(q, k, v, rel_table):
    B, H, T, Dh = q.shape
    nc = T // CHUNK
    scale = Dh ** -0.5
    qc = q.reshape(B, H, nc, CHUNK, Dh)
    pad = ((0, 0), (0, 0), (LEFT_CHUNKS * CHUNK, 0), (0, 0))
    kp = jnp.pad(k, pad).reshape(B, H, nc + LEFT_CHUNKS, CHUNK, Dh)
    vp = jnp.pad(v, pad).reshape(B, H, nc + LEFT_CHUNKS, CHUNK, Dh)
    band_idx = jnp.arange(nc)[:, None] + jnp.arange(LEFT_CHUNKS + 1)[None, :]
    k_band = kp[:, :, band_idx].reshape(B, H, nc, BAND, Dh)
    v_band = vp[:, :, band_idx].reshape(B, H, nc, BAND, Dh)
    z = jnp.einsum('bhcqd,bhckd->bhcqk', qc, k_band).astype(jnp.float32) * scale
    rel = (jnp.arange(CHUNK)[:, None] + LEFT_CHUNKS * CHUNK) - jnp.arange(BAND)[None, :]
    rel = jnp.clip(rel, -MAX_REL, MAX_REL) + MAX_REL
    bias = rel_table[rel].astype(jnp.float32).transpose(2, 0, 1)
    z = z + bias[None, :, None]
    key_abs = (jnp.arange(nc)[:, None] - LEFT_CHUNKS) * CHUNK + jnp.arange(BAND)[None, :]
    valid = key_abs >= 0
    p = jax.nn.softmax(jnp.where(valid[None, None, :, None, :], z, NEG), axis=-1)
    o = jnp.einsum('bhcqk,bhckd->bhcqd', p.astype(v.dtype), v_band)
    return o.reshape(B, H, T, Dh)


def hybrid_layer(x, g_ffn1, w_ffn1_in, w_ffn1_out, g_mix, w_in, b_in, rel_bias,
                 w_br_sb, w_br_ch, w_br_fox, w_out, g_ffn2, w_ffn2_in, w_ffn2_out):
    x = x + 0.5 * swiglu(rmsnorm(x, g_ffn1), w_ffn1_in, w_ffn1_out)
    h = rmsnorm(x, g_mix)
    proj = h @ w_in + b_in
    (q_a, k_a, v_a, q_b, k_b, v_b, q_c, k_c, v_c,
     f_logit, g_a, g_b, g_c) = jnp.split(proj, list(SPLIT_POINTS), axis=-1)
    o_a = stick_breaking_attention(split_heads(q_a, N_HEADS_SB), split_heads(k_a, N_HEADS_SB),
                                   split_heads(v_a, N_HEADS_SB))
    o_b = chunked_relpos_attention(split_heads(q_b, N_HEADS_CH), split_heads(k_b, N_HEADS_CH),
                                   split_heads(v_b, N_HEADS_CH), rel_bias)
    log_f = jax.nn.log_sigmoid(f_logit.astype(jnp.float32)).transpose(0, 2, 1)
    o_c = forgetting_attention(split_heads(q_c, N_HEADS_FOX), split_heads(k_c, N_HEADS_FOX),
                               split_heads(v_c, N_HEADS_FOX), log_f)
    merged = (jax.nn.sigmoid(g_a) * (merge_heads(o_a) @ w_br_sb)
              + jax.nn.sigmoid(g_b) * (merge_heads(o_b) @ w_br_ch)
              + jax.nn.sigmoid(g_c) * (merge_heads(o_c) @ w_br_fox))
    x = x + merged @ w_out
    x = x + 0.5 * swiglu(rmsnorm(x, g_ffn2), w_ffn2_in, w_ffn2_out)
    return x


def setup_inputs(seed: int = 0) -> dict:
    key = jax.random.key(seed)
    ks = jax.random.split(key, 18)

    def dense(k, shape, fan_in):
        return jax.random.normal(k, shape, jnp.float32) * fan_in ** -0.5

    def gain(k, shape):
        return 1.0 + 0.05 * jax.random.normal(k, shape, jnp.float32)

    b_in = 0.02 * jax.random.normal(ks[6], (DEPTH, IN_WIDTH), jnp.float32)
    b_in = b_in.at[:, FORGET_OFFSET:FORGET_OFFSET + N_HEADS_FOX].add(FORGET_BIAS_INIT)
    return {
        "x": jax.random.normal(ks[0], (BATCH, SEQ, D_MODEL), jnp.float32),
        "g_ffn1": gain(ks[1], (DEPTH, D_MODEL)),
        "w_ffn1_in": dense(ks[2], (DEPTH, D_MODEL, 2 * D_FF), D_MODEL),
        "w_ffn1_out": dense(ks[3], (DEPTH, D_FF, D_MODEL), D_FF),
        "g_mix": gain(ks[4], (DEPTH, D_MODEL)),
        "w_in": dense(ks[5], (DEPTH, D_MODEL, IN_WIDTH), D_MODEL),
        "b_in": b_in,
        "rel_bias": 0.1 * jax.random.normal(ks[7], (DEPTH, N_REL, N_HEADS_CH), jnp.float32),
        "w_br_sb": dense(ks[8], (DEPTH, W_SB, D_MODEL), W_SB),
        "w_br_ch": dense(ks[9], (DEPTH, W_CH, D_MODEL), W_CH),
        "w_br_fox": dense(ks[10], (DEPTH, W_FOX, D_MODEL), W_FOX),
        "w_out": dense(ks[11], (DEPTH, D_MODEL, D_MODEL), D_MODEL),
        "g_ffn2": gain(ks[12], (DEPTH, D_MODEL)),
        "w_ffn2_in": dense(ks[13], (DEPTH, D_MODEL, 2 * D_FF), D_MODEL),
        "w_ffn2_out": dense(ks[14], (DEPTH, D_FF, D_MODEL), D_FF),
        "g_final": gain(ks[15], (D_MODEL,)),
    }


def reference(x, g_ffn1, w_ffn1_in, w_ffn1_out, g_mix, w_in, b_in, rel_bias,
              w_br_sb, w_br_ch, w_br_fox, w_out, g_ffn2, w_ffn2_in, w_ffn2_out, g_final):
    for layer in range(DEPTH):
        x = hybrid_layer(x, g_ffn1[layer], w_ffn1_in[layer], w_ffn1_out[layer], g_mix[layer],
                         w_in[layer], b_in[layer], rel_bias[layer], w_br_sb[layer], w_br_ch[layer],
                         w_br_fox[layer], w_out[layer], g_ffn2[layer], w_ffn2_in[layer],
                         w_ffn2_out[layer])
    return rmsnorm(x, g_final)
```

```cpp
#include <hip/hip_runtime.h>
#include <hip/hip_cooperative_groups.h>
#include <cstdio>
#include <cstdint>
namespace cg = cooperative_groups;

#ifndef MFMA_MASK
#define MFMA_MASK 7u
#endif
#ifndef PROBE_ATT
#define PROBE_ATT 0
#endif
#ifndef PROBE_G1
#define PROBE_G1 0
#endif
#ifndef PROBE_SYNC
#define PROBE_SYNC 0
#endif
#ifndef MULTI_LAUNCH
#define MULTI_LAUNCH 0
#endif

namespace pg8 {
#define PG8_LAS __attribute__((address_space(3)))
typedef unsigned short bf16_t;
typedef short bf16x8 __attribute__((ext_vector_type(8)));
typedef float f32x4 __attribute__((ext_vector_type(4)));
typedef unsigned u32x4 __attribute__((ext_vector_type(4)));
typedef unsigned u32x2 __attribute__((ext_vector_type(2)));
constexpr int BM = 256, BK = 64, HALF = 128, HTB = HALF * BK * 2, STAGE_BYTES = 8 * HTB, NXCD = 8, WGM = 8;

__host__ __device__ __forceinline__ int lds_byte(int r, int c) { const int st = (r >> 4) * 2 + (c >> 5), rr = r & 15, cc = c & 31, ob = rr * 64 + cc * 2; return st * 1024 + (ob ^ (((ob >> 9) & 1) << 5)); }
__host__ __device__ __forceinline__ void stage_rc(int b, int& R, int& C) { const int st = b / 1024, sb = b % 1024, swz = sb ^ (((sb >> 9) & 1) << 5); R = (st >> 1) * 16 + swz / 64; C = (st & 1) * 32 + (swz % 64) / 2; }
__host__ __device__ __forceinline__ int perm32(int rho) { const int n = rho >> 4, i = rho & 15; return 8 * (i >> 2) + 4 * n + (i & 3); }

struct Unit { int pm, pn; };
struct Gemm { const bf16_t* A; const bf16_t* Bt; };

struct StaticOrder {
    int nM, nN, nwg, G, c;
    __host__ __device__ void init(int M, int N, int G_, int c_) { nM = M / BM; nN = N / BM; nwg = nM * nN; G = G_; c = c_; }
    __host__ __device__ bool next(int i, Unit& u) const {
        const long L = (long)i * G + c; if (L >= nwg) return false;
        int wgid = (int)L; { const int q = nwg / NXCD, r = nwg % NXCD, xcd = wgid % NXCD, off = wgid / NXCD; wgid = (xcd < r ? xcd * (q + 1) : r * (q + 1) + (xcd - r) * q) + off; }
        const int nig = WGM * nN, gid = wgid / nig, fm = gid * WGM, gsz = (nM - fm) < WGM ? (nM - fm) : WGM;
        u.pm = fm + ((wgid % nig) % gsz); u.pn = (wgid % nig) / gsz; return true;
    }
};

__device__ __forceinline__ unsigned pk_bf16(float lo, float hi) {
    typedef float f2 __attribute__((ext_vector_type(2))); typedef __bf16 b2 __attribute__((ext_vector_type(2)));
    f2 v = {lo, hi}; b2 b = __builtin_convertvector(v, b2); return __builtin_bit_cast(unsigned, b);
}
__device__ __forceinline__ float bf_lo(unsigned w) { return __uint_as_float(w << 16); }
__device__ __forceinline__ float bf_hi(unsigned w) { return __uint_as_float(w & 0xffff0000u); }
__device__ __forceinline__ float fast_sigmoid(float v) { return __builtin_amdgcn_rcpf(1.0f + __builtin_amdgcn_exp2f(-1.4426950408889634f * v)); }

constexpr int MROWS = 16384;
__device__ __forceinline__ float row_rstd(const float* part, int row) {
    const float ss = (part[row] + part[MROWS + row]) + (part[2 * MROWS + row] + part[3 * MROWS + row]);
    return 1.0f / sqrtf(ss * (1.0f / 1024.0f) + 1e-6f);
}
struct EpiSwiglu {
    static constexpr bool PERM = true, AFTER_DRAIN = false, RSTD = true, RESCALE = false, BIAS = false;
    bf16_t* H; int ldh; const float* part;
    __device__ __forceinline__ void operator()(const f32x4 (&acc)[2][2][4][2], const Unit& u, int wr, int wc, int fr, int fq, const PG8_LAS float* rsl) const {
        const int row0 = u.pm * BM + wr * 64 + fr, col0 = u.pn * HALF + wc * 32 + 8 * fq;
#pragma unroll
        for (int ai = 0; ai < 2; ++ai)
#pragma unroll
            for (int m = 0; m < 4; ++m) {
                bf16_t* p = H + (size_t)(row0 + ai * HALF + m * 16) * ldh + col0;
                const float rs = rsl[ai * HALF + wr * 64 + m * 16 + fr];
                float h[8];
#pragma unroll
                for (int n = 0; n < 2; ++n)
#pragma unroll
                    for (int e = 0; e < 4; ++e) { const float g = rs * acc[ai][0][m][n][e], up = rs * acc[ai][1][m][n][e]; h[n * 4 + e] = g * fast_sigmoid(g) * up; }
                u32x4 w; w.x = pk_bf16(h[0], h[1]); w.y = pk_bf16(h[2], h[3]); w.z = pk_bf16(h[4], h[5]); w.w = pk_bf16(h[6], h[7]);
                *(u32x4*)p = w;
            }
    }
};
struct EpiResid {
    static constexpr bool PERM = true, AFTER_DRAIN = true, RSTD = false, RESCALE = false;
    const bf16_t* base; float* out; bf16_t* xb; float* part; float* partd; const float* wf; const float* gmix; const float* gfin; unsigned* cnt; float scale;
    __device__ __forceinline__ void fused(f32x4 (&acc)[2][2][4][2], const Unit& u, int wr, int wc, int fr, int fq, PG8_LAS unsigned char* lds, int tid) const {
        const int row0 = u.pm * BM + wr * 64 + fr, col0 = u.pn * BM + wc * 32 + 8 * fq;
#pragma unroll
        for (int ai = 0; ai < 2; ++ai)
#pragma unroll
            for (int m = 0; m < 4; ++m) {
                const size_t off = (size_t)(row0 + ai * HALF + m * 16) * 1024 + col0;
#pragma unroll
                for (int bj = 0; bj < 2; ++bj) {
                    const u32x4 bw = *(const u32x4*)(base + off + bj * HALF);
                    const f32x4 b0 = {bf_lo(bw.x), bf_hi(bw.x), bf_lo(bw.y), bf_hi(bw.y)}, b1 = {bf_lo(bw.z), bf_hi(bw.z), bf_lo(bw.w), bf_hi(bw.w)};
                    const f32x4 v0 = b0 + acc[ai][bj][m][0] * scale, v1 = b1 + acc[ai][bj][m][1] * scale;
                    if (xb) { u32x4 w; w.x = pk_bf16(v0[0], v0[1]); w.y = pk_bf16(v0[2], v0[3]); w.z = pk_bf16(v1[0], v1[1]); w.w = pk_bf16(v1[2], v1[3]);
                              *(u32x4*)(xb + off + bj * HALF) = w; }
                    acc[ai][bj][m][0] = v0; acc[ai][bj][m][1] = v1;
                }
                asm volatile("" ::: "memory");
            }
        if (!xb && !gfin) return;
        float ss[8], dd[8][4];
#pragma unroll
        for (int r = 0; r < 8; ++r) { ss[r] = 0.f; dd[r][0] = 0.f; dd[r][1] = 0.f; dd[r][2] = 0.f; dd[r][3] = 0.f; }
#pragma unroll
        for (int ai = 0; ai < 2; ++ai)
#pragma unroll
            for (int m = 0; m < 4; ++m)
#pragma unroll
                for (int bj = 0; bj < 2; ++bj)
#pragma unroll
                    for (int n = 0; n < 2; ++n) { const f32x4 v = acc[ai][bj][m][n]; ss[ai * 4 + m] += (v[0] * v[0] + v[1] * v[1]) + (v[2] * v[2] + v[3] * v[3]); }
        if (partd) {
#pragma unroll
            for (int bj = 0; bj < 2; ++bj)
#pragma unroll
                for (int n = 0; n < 2; ++n) {
#pragma unroll
                    for (int e = 0; e < 4; ++e) {
                        const int c = col0 + bj * HALF + 4 * n + e;
                        const f32x4 w4 = *(const f32x4*)(wf + (size_t)c * 6148 + 3072) * gmix[c];
#pragma unroll
                        for (int ai = 0; ai < 2; ++ai)
#pragma unroll
                            for (int m = 0; m < 4; ++m) { const float x = acc[ai][bj][m][n][e];
                                dd[ai * 4 + m][0] += x * w4[0]; dd[ai * 4 + m][1] += x * w4[1]; dd[ai * 4 + m][2] += x * w4[2]; dd[ai * 4 + m][3] += x * w4[3]; }
                    }
                    asm volatile("" ::: "memory");
                }
        }
        const int lane = tid & 63;
        PG8_LAS float* red = (PG8_LAS float*)lds;
#pragma unroll
        for (int r = 0; r < 8; ++r) {
            float v = ss[r];
            v += __int_as_float(__builtin_amdgcn_ds_bpermute((lane ^ 16) << 2, __float_as_int(v)));
            v += __int_as_float(__builtin_amdgcn_ds_bpermute((lane ^ 32) << 2, __float_as_int(v)));
            const int rl = (r >> 2) * HALF + wr * 64 + (r & 3) * 16 + fr;
            if (fq == 0) red[(rl * 4 + wc) * 5] = v;
            if (partd) {
#pragma unroll
                for (int hh = 0; hh < 4; ++hh) {
                    float d = dd[r][hh];
                    d += __int_as_float(__builtin_amdgcn_ds_bpermute((lane ^ 16) << 2, __float_as_int(d)));
                    d += __int_as_float(__builtin_amdgcn_ds_bpermute((lane ^ 32) << 2, __float_as_int(d)));
                    if (fq == 0) red[(rl * 4 + wc) * 5 + 1 + hh] = d;
                }
            }
        }
        asm volatile("s_waitcnt lgkmcnt(0)" ::: "memory"); __builtin_amdgcn_s_barrier(); asm volatile("" ::: "memory");
        if (gfin) {
            if (tid < 256) { const PG8_LAS float* rp = red + tid * 20; const int gm = u.pm * BM + tid;
                __hip_atomic_store(part + (size_t)u.pn * MROWS + gm, (rp[0] + rp[5]) + (rp[10] + rp[15]), __ATOMIC_RELAXED, __HIP_MEMORY_SCOPE_AGENT); }
            asm volatile("s_waitcnt vmcnt(0)" ::: "memory"); __builtin_amdgcn_s_barrier(); asm volatile("" ::: "memory");
            if (tid == 0) {
                __hip_atomic_fetch_add(cnt + 64 * u.pm, 1u, __ATOMIC_RELAXED, __HIP_MEMORY_SCOPE_AGENT);
                unsigned spins = 0;
                while (__hip_atomic_load(cnt + 64 * u.pm, __ATOMIC_RELAXED, __HIP_MEMORY_SCOPE_AGENT) < 4u) { __builtin_amdgcn_s_sleep(2); if (++spins > (1u << 22)) break; }
                __builtin_amdgcn_fence(__ATOMIC_ACQUIRE, "agent");
            }
            asm volatile("s_waitcnt vmcnt(0) lgkmcnt(0)" ::: "memory"); __builtin_amdgcn_s_barrier(); asm volatile("" ::: "memory");
            PG8_LAS float* rsf = red + 256 * 20;
            if (tid < 256) { const int gm = u.pm * BM + tid; float ssum = 0.f;
#pragma unroll
                for (int p4 = 0; p4 < 4; ++p4) ssum += __hip_atomic_load(part + (size_t)p4 * MROWS + gm, __ATOMIC_RELAXED, __HIP_MEMORY_SCOPE_AGENT);
                rsf[tid] = 1.0f / sqrtf(ssum * (1.0f / 1024.0f) + 1e-6f); }
            asm volatile("s_waitcnt vmcnt(0) lgkmcnt(0)" ::: "memory"); __builtin_amdgcn_s_barrier(); asm volatile("" ::: "memory");
            f32x4 gv[2][2];
#pragma unroll
            for (int bj = 0; bj < 2; ++bj)
#pragma unroll
                for (int n = 0; n < 2; ++n) gv[bj][n] = *(const f32x4*)(gfin + col0 + bj * HALF + 4 * n);
#pragma unroll
            for (int ai = 0; ai < 2; ++ai)
#pragma unroll
                for (int m = 0; m < 4; ++m) {
                    const float rs = rsf[ai * HALF + wr * 64 + m * 16 + fr];
                    const size_t off = (size_t)(row0 + ai * HALF + m * 16) * 1024 + col0;
#pragma unroll
                    for (int bj = 0; bj < 2; ++bj) {
                        *(f32x4*)(out + off + bj * HALF) = acc[ai][bj][m][0] * rs * gv[bj][0];
                        *(f32x4*)(out + off + bj * HALF + 4) = acc[ai][bj][m][1] * rs * gv[bj][1];
                    }
                }
            return;
        }
        if (tid < 256) {
            const PG8_LAS float* rp = red + tid * 20; const int gm = u.pm * BM + tid;
            part[(size_t)u.pn * MROWS + gm] = (rp[0] + rp[5]) + (rp[10] + rp[15]);
            if (partd) { f32x4 o;
#pragma unroll
                for (int hh = 0; hh < 4; ++hh) o[hh] = (rp[1 + hh] + rp[6 + hh]) + (rp[11 + hh] + rp[16 + hh]);
                *(f32x4*)(partd + ((size_t)u.pn * MROWS + gm) * 4) = o; }
        }
    }
};
struct EpiQKVG {
    static constexpr bool PERM = true, AFTER_DRAIN = false, RSTD = true, RESCALE = false, BIAS = true;
    bf16_t* QKV; bf16_t* G; const float* bias; const float* part;
    __device__ __forceinline__ void operator()(const f32x4 (&acc)[2][2][4][2], const Unit& u, int wr, int wc, int fr, int fq, const PG8_LAS float* rsl) const {
        const int row0 = u.pm * BM + wr * 64 + fr;
        const bool gate = u.pn >= 12;
        const int pnl = gate ? u.pn - 12 : u.pn;
        const int col0 = pnl * BM + wc * 32 + 8 * fq;
        const int bcol0 = u.pn * BM + wc * 32 + 8 * fq + (gate ? 4 : 0);
        bf16_t* dst = gate ? G : QKV;
        const bool isq = (u.pn == 0) || (u.pn == 3) || (u.pn == 4) || (u.pn == 9);
        const float sc = isq ? (u.pn == 0 ? 0.125f : 0.125f * 1.4426950408889634f) : 1.0f;
        float bv[2][8];
#pragma unroll
        for (int bj = 0; bj < 2; ++bj)
#pragma unroll
            for (int e = 0; e < 8; ++e) bv[bj][e] = rsl[2048 + bj * HALF + wc * 32 + 8 * fq + e];
        (void)bcol0;
#pragma unroll
        for (int ai = 0; ai < 2; ++ai)
#pragma unroll
            for (int m = 0; m < 4; ++m) {
                bf16_t* p = dst + (size_t)(row0 + ai * HALF + m * 16) * 3072 + col0;
                const float rs = rsl[ai * HALF + wr * 64 + m * 16 + fr];
#pragma unroll
                for (int bj = 0; bj < 2; ++bj) {
                    float v[8];
#pragma unroll
                    for (int n = 0; n < 2; ++n)
#pragma unroll
                        for (int e = 0; e < 4; ++e) { float t = rs * acc[ai][bj][m][n][e] + bv[bj][n * 4 + e]; v[n * 4 + e] = gate ? fast_sigmoid(t) : t * sc; }
                    u32x4 w; w.x = pk_bf16(v[0], v[1]); w.y = pk_bf16(v[2], v[3]); w.z = pk_bf16(v[4], v[5]); w.w = pk_bf16(v[6], v[7]);
                    *(u32x4*)(p + bj * HALF) = w;
                }
            }
    }
};
struct EpiBranch {
    static constexpr bool PERM = true, AFTER_DRAIN = false, RSTD = false, RESCALE = false;
    const bf16_t* G; float* T; bf16_t* merged; int mode;
    __device__ __forceinline__ void operator()(const f32x4 (&acc)[2][2][4][2], const Unit& u, int wr, int wc, int fr, int fq, const PG8_LAS float*) const {
        const int row0 = u.pm * BM + wr * 64 + fr, col0 = u.pn * BM + wc * 32 + 8 * fq;
#pragma unroll
        for (int ai = 0; ai < 2; ++ai)
#pragma unroll
            for (int m = 0; m < 4; ++m) {
                const size_t row = (size_t)(row0 + ai * HALF + m * 16);
#pragma unroll
                for (int bj = 0; bj < 2; ++bj) {
                    const u32x4 gw = *(const u32x4*)(G + row * 3072 + col0 + bj * HALF);
                    f32x4 v0, v1;
                    v0[0] = bf_lo(gw.x) * acc[ai][bj][m][0][0]; v0[1] = bf_hi(gw.x) * acc[ai][bj][m][0][1];
                    v0[2] = bf_lo(gw.y) * acc[ai][bj][m][0][2]; v0[3] = bf_hi(gw.y) * acc[ai][bj][m][0][3];
                    v1[0] = bf_lo(gw.z) * acc[ai][bj][m][1][0]; v1[1] = bf_hi(gw.z) * acc[ai][bj][m][1][1];
                    v1[2] = bf_lo(gw.w) * acc[ai][bj][m][1][2]; v1[3] = bf_hi(gw.w) * acc[ai][bj][m][1][3];
                    float* tp = T + row * 1024 + col0 + bj * HALF;
                    if (mode != 0) { v0 += *(const f32x4*)tp; v1 += *(const f32x4*)(tp + 4); }
                    if (mode != 2) { *(f32x4*)tp = v0; *(f32x4*)(tp + 4) = v1; }
                    else { u32x4 w; w.x = pk_bf16(v0[0], v0[1]); w.y = pk_bf16(v0[2], v0[3]); w.z = pk_bf16(v1[0], v1[1]); w.w = pk_bf16(v1[2], v1[3]);
                           *(u32x4*)(merged + row * 1024 + col0 + bj * HALF) = w; }
                }
                asm volatile("" ::: "memory");
            }
    }
};

struct EpiBranch1 {
    static constexpr bool PERM = true, AFTER_DRAIN = false, RSTD = false, RESCALE = true;
    const bf16_t* G; bf16_t* merged;
    static __device__ __forceinline__ float fl(float g) { return fmaxf(g, 1e-30f); }
    __device__ __forceinline__ void rescale(f32x4 (&acc)[2][2][4][2], const Unit& u, int wr, int wc, int fr, int fq, int from) const {
        const int row0 = u.pm * BM + wr * 64 + fr, col0 = u.pn * BM + wc * 32 + 8 * fq + from * 1024;
#pragma unroll
        for (int ai = 0; ai < 2; ++ai)
#pragma unroll
            for (int m = 0; m < 4; ++m) {
                const bf16_t* gp = G + (size_t)(row0 + ai * HALF + m * 16) * 3072 + col0;
#pragma unroll
                for (int bj = 0; bj < 2; ++bj) {
                    const u32x4 a = *(const u32x4*)(gp + bj * HALF), b = *(const u32x4*)(gp + bj * HALF + 1024);
                    acc[ai][bj][m][0][0] *= fl(bf_lo(a.x)) * __builtin_amdgcn_rcpf(fl(bf_lo(b.x))); acc[ai][bj][m][0][1] *= fl(bf_hi(a.x)) * __builtin_amdgcn_rcpf(fl(bf_hi(b.x)));
                    acc[ai][bj][m][0][2] *= fl(bf_lo(a.y)) * __builtin_amdgcn_rcpf(fl(bf_lo(b.y))); acc[ai][bj][m][0][3] *= fl(bf_hi(a.y)) * __builtin_amdgcn_rcpf(fl(bf_hi(b.y)));
                    acc[ai][bj][m][1][0] *= fl(bf_lo(a.z)) * __builtin_amdgcn_rcpf(fl(bf_lo(b.z))); acc[ai][bj][m][1][1] *= fl(bf_hi(a.z)) * __builtin_amdgcn_rcpf(fl(bf_hi(b.z)));
                    acc[ai][bj][m][1][2] *= fl(bf_lo(a.w)) * __builtin_amdgcn_rcpf(fl(bf_lo(b.w))); acc[ai][bj][m][1][3] *= fl(bf_hi(a.w)) * __builtin_amdgcn_rcpf(fl(bf_hi(b.w)));
                }
            }
    }
    __device__ __forceinline__ void operator()(const f32x4 (&acc)[2][2][4][2], const Unit& u, int wr, int wc, int fr, int fq, const PG8_LAS float*) const {
        const int row0 = u.pm * BM + wr * 64 + fr, col0 = u.pn * BM + wc * 32 + 8 * fq;
#pragma unroll
        for (int ai = 0; ai < 2; ++ai)
#pragma unroll
            for (int m = 0; m < 4; ++m) {
                const size_t row = (size_t)(row0 + ai * HALF + m * 16);
#pragma unroll
                for (int bj = 0; bj < 2; ++bj) {
                    const u32x4 g = *(const u32x4*)(G + row * 3072 + 2048 + col0 + bj * HALF);
                    u32x4 w;
                    w.x = pk_bf16(acc[ai][bj][m][0][0] * fl(bf_lo(g.x)), acc[ai][bj][m][0][1] * fl(bf_hi(g.x)));
                    w.y = pk_bf16(acc[ai][bj][m][0][2] * fl(bf_lo(g.y)), acc[ai][bj][m][0][3] * fl(bf_hi(g.y)));
                    w.z = pk_bf16(acc[ai][bj][m][1][0] * fl(bf_lo(g.z)), acc[ai][bj][m][1][1] * fl(bf_hi(g.z)));
                    w.w = pk_bf16(acc[ai][bj][m][1][2] * fl(bf_lo(g.w)), acc[ai][bj][m][1][3] * fl(bf_hi(g.w)));
                    *(u32x4*)(merged + row * 1024 + col0 + bj * HALF) = w;
                }
                if (m & 1) asm volatile("" ::: "memory");
            }
    }
};

template <class Epi, class Sched, int K_, int LDA_, int LDB_>
__device__ __forceinline__ void gemm_phase(PG8_LAS unsigned char* lds, const Gemm g, const Sched S, const Epi E) {
    int tid_ = threadIdx.x; asm volatile("" : "+v"(tid_));
    const int tid = tid_, wid = __builtin_amdgcn_readfirstlane(tid >> 6), lane = tid & 63, wr = wid >> 2, wc = wid & 3, fr = lane & 15, fq = lane >> 4;
    constexpr int nt = K_ / BK;
    unsigned voffA[2], voffB[2];
#pragma unroll
    for (int i = 0; i < 2; ++i) { int R, C; stage_rc(tid * 16 + i * 8192, R, C); const int Rb = Epi::PERM ? ((R & ~31) + perm32(R & 31)) : R;
        voffA[i] = (unsigned)(R * LDA_ + C) * 2u; voffB[i] = (unsigned)(Rb * LDB_ + C) * 2u; }
    constexpr size_t kstep = (size_t)(BK * 2);
    constexpr size_t hstepA = (size_t)HALF * LDA_ * 2, hstepB = (size_t)HALF * LDB_ * 2;
    constexpr size_t tstepA = 2 * hstepA, tstepB = 2 * hstepB;
    const unsigned ldsw = (unsigned)wid * 1024u;
    const int aoff = lds_byte(wr * 64 + fr, fq * 8), boff = lds_byte(wc * 32 + fr, fq * 8);
#define PG8_SA(b, h) (((b) * 2 + (h)) * HTB)
#define PG8_SB(b, h) ((4 + (b) * 2 + (h)) * HTB)
#define PG8_STAGE(bufoff, gbase, voff) do { _Pragma("unroll") for (int _i = 0; _i < 2; ++_i) \
        __builtin_amdgcn_global_load_lds((const unsigned*)((const char*)(gbase) + (voff)[_i]), (PG8_LAS unsigned*)(lds + (bufoff) + ldsw + _i * 8192), 16, 0, 0); } while (0)
#define PG8_LDA(dst, b, h) do { _Pragma("unroll") for (int m = 0; m < 4; ++m) _Pragma("unroll") for (int k = 0; k < 2; ++k) dst[m][k] = *(const PG8_LAS bf16x8*)(lds + PG8_SA(b, h) + aoff + m * 2048 + k * 1024); } while (0)
#define PG8_LDB(dst, b, h) do { _Pragma("unroll") for (int n = 0; n < 2; ++n) _Pragma("unroll") for (int k = 0; k < 2; ++k) dst[n][k] = *(const PG8_LAS bf16x8*)(lds + PG8_SB(b, h) + boff + n * 2048 + k * 1024); } while (0)
#define PG8_MMA(ai, bj, At, Bt) do { __builtin_amdgcn_s_setprio(1); _Pragma("unroll") for (int m = 0; m < 4; ++m) _Pragma("unroll") for (int n = 0; n < 2; ++n) _Pragma("unroll") for (int k = 0; k < 2; ++k) \
        acc[ai][bj][m][n] = __builtin_amdgcn_mfma_f32_16x16x32_bf16(Bt[n][k], At[m][k], acc[ai][bj][m][n], 0, 0, 0); __builtin_amdgcn_s_setprio(0); } while (0)
#define PG8_WAIT_V(n) asm volatile("s_waitcnt vmcnt(" #n ")" ::: "memory")
#define PG8_WAIT_L(n) asm volatile("s_waitcnt lgkmcnt(" #n ")" ::: "memory")
#define PG8_BAR __builtin_amdgcn_s_barrier()
#define PG8_SCHED __builtin_amdgcn_sched_barrier(0)
    Unit cur, nxt; int ui = 0;
    if (!S.next(0, cur)) return;
    PG8_LAS float* rsl = (PG8_LAS float*)(lds + STAGE_BYTES);
    f32x4 acc[2][2][4][2];
#pragma unroll
    for (int a = 0; a < 2; ++a)
#pragma unroll
        for (int b = 0; b < 2; ++b)
#pragma unroll
            for (int m = 0; m < 4; ++m)
#pragma unroll
                for (int n = 0; n < 2; ++n) acc[a][b][m][n] = (f32x4){0.f, 0.f, 0.f, 0.f};
    bf16x8 At[4][2], B0[2][2], B1[2][2];
    const char* cA = (const char*)g.A + (size_t)cur.pm * tstepA; const char* cB = (const char*)g.Bt + (size_t)cur.pn * tstepB;
    PG8_STAGE(PG8_SB(0, 0), cB, voffB); PG8_STAGE(PG8_SB(0, 1), cB + hstepB, voffB); PG8_STAGE(PG8_SA(0, 0), cA, voffA); PG8_STAGE(PG8_SA(0, 1), cA + hstepA, voffA);
    if constexpr (Epi::RSTD) {
        Unit uu;
        for (int i = 0; i < 8 && S.next(i, uu); ++i) if (tid < 256) {
            rsl[i * 256 + tid] = row_rstd(E.part, uu.pm * BM + tid);
            if constexpr (Epi::BIAS) { if (i < 6) rsl[2048 + i * 256 + tid] = E.bias[uu.pn * BM + tid + (uu.pn >= 12 ? 4 : 0)]; }
        }
        asm volatile("s_waitcnt lgkmcnt(0)" ::: "memory"); __builtin_amdgcn_s_barrier(); asm volatile("" ::: "memory");
    }
    if (wr == 1) PG8_BAR;
    PG8_WAIT_V(2); PG8_BAR;
    PG8_STAGE(PG8_SB(1, 0), cB + kstep, voffB); PG8_STAGE(PG8_SA(1, 0), cA + kstep, voffA); PG8_STAGE(PG8_SB(1, 1), cB + hstepB + kstep, voffB);
    PG8_WAIT_V(6); PG8_BAR;
    for (;;) {
        const bool has_next = S.next(ui + 1, nxt);
        const char* nA = has_next ? (const char*)g.A + (size_t)nxt.pm * tstepA : cA; const char* nB = has_next ? (const char*)g.Bt + (size_t)nxt.pn * tstepB : cB;
        for (int t = 0; t < nt; t += 2) {
            if constexpr (Epi::RESCALE) {
                if (t == 4 || t == 12) { int t3 = threadIdx.x; asm volatile("" : "+v"(t3)); const int l3 = t3 & 63; E.rescale(acc, cur, wr, wc, l3 & 15, l3 >> 4, t == 4 ? 0 : 1); }
            }
            const bool last = (t == nt - 2);
            const char* a1 = cA + (size_t)(t + 1) * kstep;
            const char* a2 = last ? nA : cA + (size_t)(t + 2) * kstep; const char* b2 = last ? nB : cB + (size_t)(t + 2) * kstep;
            const char* a3 = a2 + kstep; const char* b3 = b2 + kstep;
            PG8_LDB(B0, 0, 0); PG8_LDB(B1, 0, 1); PG8_SCHED; PG8_LDA(At, 0, 0); PG8_STAGE(PG8_SA(1, 1), a1 + hstepA, voffA);
            PG8_WAIT_V(8); PG8_WAIT_L(0); PG8_BAR; PG8_MMA(0, 0, At, B0); PG8_MMA(0, 1, At, B1); PG8_BAR; PG8_SCHED;
            PG8_LDA(At, 0, 1); PG8_STAGE(PG8_SB(0, 0), b2, voffB); PG8_STAGE(PG8_SB(0, 1), b2 + hstepB, voffB); PG8_STAGE(PG8_SA(0, 0), a2, voffA);
            PG8_WAIT_V(8); PG8_WAIT_L(0); PG8_BAR; PG8_MMA(1, 0, At, B0); PG8_MMA(1, 1, At, B1); PG8_BAR; PG8_SCHED;
            PG8_LDB(B0, 1, 0); PG8_LDB(B1, 1, 1); PG8_SCHED; PG8_LDA(At, 1, 0); PG8_STAGE(PG8_SA(0, 1), a2 + hstepA, voffA);
            PG8_WAIT_V(8); PG8_WAIT_L(0); PG8_BAR; PG8_MMA(0, 0, At, B0); PG8_MMA(0, 1, At, B1); PG8_BAR; PG8_SCHED;
            PG8_LDA(At, 1, 1); PG8_STAGE(PG8_SB(1, 0), b3, voffB); PG8_STAGE(PG8_SB(1, 1), b3 + hstepB, voffB); PG8_STAGE(PG8_SA(1, 0), a3, voffA);
            PG8_WAIT_V(8); PG8_WAIT_L(0); PG8_BAR; PG8_MMA(1, 0, At, B0); PG8_MMA(1, 1, At, B1); PG8_BAR; PG8_SCHED;
        }
        if (wr == 0) PG8_BAR;
        { int t2 = threadIdx.x; asm volatile("" : "+v"(t2));
          const int l2 = t2 & 63; if constexpr (!Epi::AFTER_DRAIN) E(acc, cur, wr, wc, l2 & 15, l2 >> 4, rsl + ui * 256); }
        if (!has_next) break;
#pragma unroll
        for (int a = 0; a < 2; ++a)
#pragma unroll
            for (int b = 0; b < 2; ++b)
#pragma unroll
                for (int m = 0; m < 4; ++m)
#pragma unroll
                    for (int n = 0; n < 2; ++n) acc[a][b][m][n] = (f32x4){0.f, 0.f, 0.f, 0.f};
        cur = nxt; cA = nA; cB = nB; ++ui;
        if (wr == 1) PG8_BAR;
    }
    PG8_WAIT_V(0);
    PG8_BAR;
    if constexpr (Epi::AFTER_DRAIN) { int t2 = threadIdx.x; asm volatile("" : "+v"(t2)); const int l2 = t2 & 63; E.fused(acc, cur, wr, wc, l2 & 15, l2 >> 4, lds, t2); PG8_BAR; }
#undef PG8_SA
#undef PG8_SB
#undef PG8_STAGE
#undef PG8_LDA
#undef PG8_LDB
#undef PG8_MMA
#undef PG8_WAIT_V
#undef PG8_WAIT_L
#undef PG8_BAR
#undef PG8_SCHED
}
}

typedef unsigned short bf16;
typedef float f32x4 __attribute__((ext_vector_type(4)));
typedef unsigned v4u __attribute__((ext_vector_type(4)));
typedef unsigned v2u __attribute__((ext_vector_type(2)));
#define LAS __attribute__((address_space(3)))
constexpr int DM = 1024, NB = 8, SEQ = 2048, M = NB * SEQ, DFF = 2816, INW = 6148, QW = 3072, NREL = 257;
constexpr int NWAVES = 8;
constexpr float RMS_EPS = 1e-6f;
constexpr float LOG2E = 1.4426950408889634f, LN2 = 0.6931471805599453f;

constexpr size_t MiB = 1u << 20;
constexpr size_t WS_CTL = 0;
constexpr int CW_BAR = 1024;
constexpr int CW_PANEL = 8192;
constexpr size_t WS_PART = 64 * 1024;
constexpr size_t WS_FC = WS_PART + 256 * 1024;
constexpr size_t WS_WMIX = 1 * MiB;
constexpr size_t WMIX_LAYER = 16 * MiB, WMIX_BR = 12 * MiB, WMIX_OUT = 14 * MiB;
constexpr size_t WS_XN = 33 * MiB;
constexpr size_t WS_R1 = 65 * MiB;
constexpr size_t WS_MERGED = WS_R1, WS_T = WS_R1 + 32 * MiB;
constexpr size_t FFN_SLOT = 17 * MiB, FFN_SLOT_OUT = 11 * MiB;
constexpr size_t WS_R2 = 161 * MiB;
constexpr size_t WS_PARTD = 257 * MiB;
constexpr size_t WS_END = 258 * MiB;
static_assert(WS_END <= 272000000ull, "workspace budget");
static_assert(3 * FFN_SLOT <= 64 * MiB, "ffn slots inside T");

constexpr int LDS_BYTES = 147456;

__device__ __forceinline__ unsigned f2bf(float f) { unsigned u = __builtin_bit_cast(unsigned, f); return (u + 0x7fffu + ((u >> 16) & 1u)) >> 16; }
__device__ __forceinline__ unsigned pk2(float lo, float hi) { return f2bf(lo) | (f2bf(hi) << 16); }
__device__ __forceinline__ float bf2f(bf16 v) { return __uint_as_float(((unsigned)v) << 16); }
__device__ __forceinline__ float wave_sum(float v, int lane) {
#pragma unroll
    for (int o = 1; o < 64; o <<= 1) v += __int_as_float(__builtin_amdgcn_ds_bpermute((lane ^ o) << 2, __float_as_int(v)));
    return v;
}

__device__ __forceinline__ void tr_item(const float* W, int N, int k0, int n0, bf16* WT, int ldt, int drow0, int dk0, LAS float* scr, int lane, const float* gk) {
    const int c4 = 4 * (lane & 7), r8 = lane >> 3;
    f32x4 v[8];
#pragma unroll
    for (int i = 0; i < 8; ++i) v[i] = __builtin_nontemporal_load((const f32x4*)(W + (size_t)(k0 + 8 * i + r8) * N + n0 + c4));
#pragma unroll
    for (int i = 0; i < 8; ++i) { LAS float* d = scr + (8 * i + r8) * 33 + c4; d[0] = v[i][0]; d[1] = v[i][1]; d[2] = v[i][2]; d[3] = v[i][3]; }
    asm volatile("s_waitcnt lgkmcnt(0)" ::: "memory");
    const int c = lane & 7;
    f32x4 ga = {1.f, 1.f, 1.f, 1.f}, gb = {1.f, 1.f, 1.f, 1.f};
    if (gk) { ga = *(const f32x4*)(gk + k0 + 8 * c); gb = *(const f32x4*)(gk + k0 + 8 * c + 4); }
#pragma unroll
    for (int j = 0; j < 4; ++j) { const int n = (lane >> 3) + 8 * j; const LAS float* s = scr + (8 * c) * 33 + n;
        v4u o; o.x = pk2(s[0 * 33] * ga[0], s[1 * 33] * ga[1]); o.y = pk2(s[2 * 33] * ga[2], s[3 * 33] * ga[3]); o.z = pk2(s[4 * 33] * gb[0], s[5 * 33] * gb[1]); o.w = pk2(s[6 * 33] * gb[2], s[7 * 33] * gb[3]);
        *(v4u*)(WT + (size_t)(drow0 + n) * ldt + dk0 + k0 + 8 * c) = o; }
    asm volatile("s_waitcnt lgkmcnt(0)" ::: "memory");
}
__device__ __forceinline__ void conv_matrix(const float* W, int K, int N, int nblk, int kind, bf16* WT, int ldt, int dk0, LAS float* scr, int gw, int NGW, int lane, const float* gk = nullptr, int off = 0) {
    const int nitems = (K / 64) * nblk;
    for (int it = (gw + NGW - off % NGW) % NGW; it < nitems; it += NGW) {
        const int kb = it / nblk, nb = it % nblk;
        int n0 = 32 * nb, drow0 = n0;
        if (kind == 1) { const int up = n0 >= DFF, j0 = n0 - up * DFF; drow0 = (j0 >> 7) * 256 + (j0 & 127) + up * 128; }
        else if (kind == 2) { if (nb >= 96) n0 += 4; }
        tr_item(W, N, 64 * kb, n0, WT, ldt, drow0, dk0, scr, lane, gk);
    }
}

struct Args { const float* in[16]; float* out; unsigned char* ws; int ph_lo, ph_hi; };
constexpr int PTAB_OFF = 147456 - 256;
#define GAS_ __attribute__((address_space(1)))
#define PTR_(i) ((const float*)(GAS_ const float*)ld_ptr(lds, (i)))
__device__ __forceinline__ unsigned long long ld_ptr(LAS unsigned char* lds, int i) {
    const unsigned long long v = *((volatile LAS unsigned long long*)(lds + PTAB_OFF) + i);
    const unsigned lo = __builtin_amdgcn_readfirstlane((unsigned)v), hi = __builtin_amdgcn_readfirstlane((unsigned)(v >> 32));
    return ((unsigned long long)hi << 32) | lo;
}

__device__ __forceinline__ void conv_ffn(LAS unsigned char* lds, unsigned char* ws, int layer, int which  , int slot, LAS float* scr, int gw, int NGW, int lane, int parts = 3  , int off = 0) {
    const float* win = PTR_(which ? 13 : 2) + (size_t)layer * DM * 2 * DFF;
    const float* wout = PTR_(which ? 14 : 3) + (size_t)layer * DFF * DM;
    bf16* s = (bf16*)(ws + WS_T + (size_t)slot * FFN_SLOT);
    if (parts & 1) { conv_matrix(win, DM, 2 * DFF, 2 * DFF / 32, 1, s, DM, 0, scr, gw, NGW, lane, PTR_(which ? 12 : 1) + layer * DM, off); off += 2816; }
    if (parts & 2) conv_matrix(wout, DFF, DM, DM / 32, 0, (bf16*)((unsigned char*)s + FFN_SLOT_OUT), DFF, 0, scr, gw, NGW, lane, nullptr, off);
}
__device__ __forceinline__ void conv_mix(LAS unsigned char* lds, unsigned char* ws, int layer, LAS float* scr, int gw, int NGW, int lane, int off = 0) {
    unsigned char* wb = ws + WS_WMIX + (size_t)layer * WMIX_LAYER;
    conv_matrix(PTR_(5) + (size_t)layer * DM * INW, DM, INW, 192, 2, (bf16*)wb, DM, 0, scr, gw, NGW, lane, PTR_(4) + layer * DM, off);
    conv_matrix(PTR_(8) + (size_t)layer * 256 * DM, 256, DM, 32, 0, (bf16*)(wb + WMIX_BR), DM, 0, scr, gw, NGW, lane, nullptr, off + 3072);
    conv_matrix(PTR_(9) + (size_t)layer * 512 * DM, 512, DM, 32, 0, (bf16*)(wb + WMIX_BR), DM, 256, scr, gw, NGW, lane, nullptr, off + 3200);
    conv_matrix(PTR_(10) + (size_t)layer * 256 * DM, 256, DM, 32, 0, (bf16*)(wb + WMIX_BR), DM, 768, scr, gw, NGW, lane, nullptr, off + 3456);
    conv_matrix(PTR_(11) + (size_t)layer * DM * DM, DM, DM, 32, 0, (bf16*)(wb + WMIX_OUT), DM, 0, scr, gw, NGW, lane, nullptr, off + 3584);
}

template <int MODE>
__device__ __forceinline__ void norm_rows(const float* x, const float* g, bf16* xn, float* fout, const float* wf  , const float* bf_, float* fl, int gw, int NGW, int lane) {
    f32x4 gv[4];
#pragma unroll
    for (int j = 0; j < 4; ++j) gv[j] = *((const f32x4*)g + 64 * j + lane);
    f32x4 wv[4][4];
    if (MODE == 1) {
#pragma unroll
        for (int j = 0; j < 4; ++j)
#pragma unroll
            for (int e = 0; e < 4; ++e) { const int k = 256 * j + 4 * lane + e; const f32x4 w4 = *(const f32x4*)(wf + (size_t)k * INW + QW);
                wv[0][j][e] = w4[0]; wv[1][j][e] = w4[1]; wv[2][j][e] = w4[2]; wv[3][j][e] = w4[3]; }
    }
    for (int m = gw; m < M; m += NGW) {
        const f32x4* xr = (const f32x4*)(x + (size_t)m * DM) + lane;
        f32x4 v[4]; float s = 0.f;
#pragma unroll
        for (int j = 0; j < 4; ++j) { v[j] = xr[64 * j]; s += (v[j][0] * v[j][0] + v[j][1] * v[j][1]) + (v[j][2] * v[j][2] + v[j][3] * v[j][3]); }
        const float rstd = 1.0f / sqrtf(wave_sum(s, lane) * (1.0f / DM) + RMS_EPS);
#pragma unroll
        for (int j = 0; j < 4; ++j) v[j] = v[j] * rstd * gv[j];
        if (MODE == 2) {
            f32x4* o = (f32x4*)(fout + (size_t)m * DM) + lane;
#pragma unroll
            for (int j = 0; j < 4; ++j) o[64 * j] = v[j];
        } else {
            v2u* o8 = (v2u*)(xn + (size_t)m * DM) + lane;
#pragma unroll
            for (int j = 0; j < 4; ++j) { v2u w; w.x = pk2(v[j][0], v[j][1]); w.y = pk2(v[j][2], v[j][3]); o8[64 * j] = w; }
        }
        if (MODE == 1) {
            float d[4];
#pragma unroll
            for (int h = 0; h < 4; ++h) { float t = 0.f;
#pragma unroll
                for (int j = 0; j < 4; ++j) t += (v[j][0] * wv[h][j][0] + v[j][1] * wv[h][j][1]) + (v[j][2] * wv[h][j][2] + v[j][3] * wv[h][j][3]);
                d[h] = wave_sum(t, lane); }
            if (lane < 4) { const float z = (lane == 0 ? d[0] : lane == 1 ? d[1] : lane == 2 ? d[2] : d[3]) + bf_[lane];
                const float lf = fminf(z, 0.f) - log1pf(expf(-fabsf(z)));
                const int b = m / SEQ, t = m % SEQ; fl[(size_t)(b * 4 + lane) * SEQ + t] = lf; }
        }
    }
}

__device__ __forceinline__ void rows_raw(const float* x, bf16* xb, float* part, int gw, int NGW, int lane) {
    for (int m = gw; m < M; m += NGW) {
        const f32x4* xr = (const f32x4*)(x + (size_t)m * DM) + lane;
        f32x4 v[4]; float s = 0.f;
#pragma unroll
        for (int j = 0; j < 4; ++j) { v[j] = __builtin_nontemporal_load(xr + 64 * j); s += (v[j][0] * v[j][0] + v[j][1] * v[j][1]) + (v[j][2] * v[j][2] + v[j][3] * v[j][3]); }
        s = wave_sum(s, lane);
        v2u* o8 = (v2u*)(xb + (size_t)m * DM) + lane;
#pragma unroll
        for (int j = 0; j < 4; ++j) { v2u w; w.x = pk2(v[j][0], v[j][1]); w.y = pk2(v[j][2], v[j][3]); o8[64 * j] = w; }
        if (lane < 4) part[(size_t)lane * M + m] = lane == 0 ? s : 0.f;
    }
}

__device__ __forceinline__ void cumsum_seq(const float* part, const float* partd, const float* bfg  , float* fc, int seq, LAS float* scr, int tid) {
    const int lane = tid & 63, wid = tid >> 6, b = seq >> 2, hh = seq & 3;
    const float bias = bfg[hh];
    float lf[4];
#pragma unroll
    for (int e = 0; e < 4; ++e) {
        const int m = b * SEQ + 4 * tid + e;
        const float rs = pg8::row_rstd(part, m);
        const float dot = (partd[((size_t)m) * 4 + hh] + partd[((size_t)M + m) * 4 + hh]) + (partd[((size_t)2 * M + m) * 4 + hh] + partd[((size_t)3 * M + m) * 4 + hh]);
        const float z = rs * dot + bias;
        lf[e] = fminf(z, 0.f) - log1pf(expf(-fabsf(z)));
    }
    const float s1 = lf[0], s2 = s1 + lf[1], s3 = s2 + lf[2], s4 = s3 + lf[3];
    float inc = s4;
#pragma unroll
    for (int o = 1; o < 64; o <<= 1) { const float t = __int_as_float(__builtin_amdgcn_ds_bpermute(((lane - o) & 63) << 2, __float_as_int(inc))); if (lane >= o) inc += t; }
    if (lane == 63) scr[wid] = inc;
    __syncthreads();
    float base = 0.f;
    for (int w = 0; w < wid; ++w) base += scr[w];
    const float ex = base + inc - s4;
    f32x4 o; o[0] = ex + s1; o[1] = ex + s2; o[2] = ex + s3; o[3] = ex + s4;
    *((f32x4*)(fc + (size_t)seq * SEQ) + tid) = o * (-LOG2E);
    __syncthreads();
}

#define DOT64(z, q, kp) do { z = 0.f; _Pragma("unroll") for (int c_ = 0; c_ < 8; ++c_) { const v4u w_ = *((const v4u*)(kp) + c_); const v4u q_ = q[c_]; \
    z += pg8::bf_lo(q_[0]) * pg8::bf_lo(w_[0]) + pg8::bf_hi(q_[0]) * pg8::bf_hi(w_[0]) + pg8::bf_lo(q_[1]) * pg8::bf_lo(w_[1]) + pg8::bf_hi(q_[1]) * pg8::bf_hi(w_[1]) \
       + pg8::bf_lo(q_[2]) * pg8::bf_lo(w_[2]) + pg8::bf_hi(q_[2]) * pg8::bf_hi(w_[2]) + pg8::bf_lo(q_[3]) * pg8::bf_lo(w_[3]) + pg8::bf_hi(q_[3]) * pg8::bf_hi(w_[3]); } } while (0)
#define AXPY64(o, wt_, vp) do { _Pragma("unroll") for (int c_ = 0; c_ < 8; ++c_) { const v4u w_ = *((const v4u*)(vp) + c_); \
    o[c_ * 8 + 0] += (wt_) * pg8::bf_lo(w_[0]); o[c_ * 8 + 1] += (wt_) * pg8::bf_hi(w_[0]); o[c_ * 8 + 2] += (wt_) * pg8::bf_lo(w_[1]); o[c_ * 8 + 3] += (wt_) * pg8::bf_hi(w_[1]); \
    o[c_ * 8 + 4] += (wt_) * pg8::bf_lo(w_[2]); o[c_ * 8 + 5] += (wt_) * pg8::bf_hi(w_[2]); o[c_ * 8 + 6] += (wt_) * pg8::bf_lo(w_[3]); o[c_ * 8 + 7] += (wt_) * pg8::bf_hi(w_[3]); } } while (0)
#define LOADQ(q, qp) do { _Pragma("unroll") for (int c_ = 0; c_ < 8; ++c_) q[c_] = *((const v4u*)(qp) + c_); } while (0)
#define STOREO(op, o, sc) do { _Pragma("unroll") for (int c_ = 0; c_ < 8; ++c_) { v4u w_; w_.x = pk2(o[c_ * 8 + 0] * (sc), o[c_ * 8 + 1] * (sc)); w_.y = pk2(o[c_ * 8 + 2] * (sc), o[c_ * 8 + 3] * (sc)); \
    w_.z = pk2(o[c_ * 8 + 4] * (sc), o[c_ * 8 + 5] * (sc)); w_.w = pk2(o[c_ * 8 + 6] * (sc), o[c_ * 8 + 7] * (sc)); *((v4u*)(op) + c_) = w_; } } while (0)

__device__ __forceinline__ void attn_naive(const bf16* QKV, bf16* O, const float* fc, const float* rel  , int gw, int NGW, int lane, unsigned mask) {
    for (int wu = gw; wu < 4096; wu += NGW) {
        { const int mx_ = wu < 1024 ? 0 : (wu < 2048 ? 2 : 1); if (!((mask >> mx_) & 1u)) continue; }
        v4u q[8]; float o[64];
#pragma unroll
        for (int d = 0; d < 64; ++d) o[d] = 0.f;
        if (wu < 1024) {
            const int blk = 31 - (wu >> 5), bh = wu & 31, b = bh >> 2, h = bh & 3;
            const int t = blk * 64 + lane; const size_t row = (size_t)b * SEQ + t;
            const bf16* kb = QKV + (size_t)b * SEQ * QW + 256 + h * 64; const bf16* vb = kb + 256;
            LOADQ(q, QKV + row * QW + h * 64);
            float R = 0.f;
            for (int s = blk * 64 + 62; s >= 0; --s) {
                float z; DOT64(z, q, kb + (size_t)s * QW);
                const bool act = s < t;
                const float sp = fmaxf(z, 0.f) + log1pf(expf(-fabsf(z)));
                const float w = act ? expf(z - sp + R) : 0.f;
                R -= act ? sp : 0.f;
                AXPY64(o, w, vb + (size_t)s * QW);
            }
            STOREO(O + row * DM + h * 64, o, 1.0f);
        } else if (wu < 2048) {
            const int u = wu - 1024; const int blk = 31 - (u >> 5), bh = u & 31, b = bh >> 2, h = bh & 3;
            const int t = blk * 64 + lane; const size_t row = (size_t)b * SEQ + t;
            const bf16* kb = QKV + (size_t)b * SEQ * QW + 2560 + h * 64; const bf16* vb = kb + 256;
            const float* F = fc + (size_t)bh * SEQ;
            LOADQ(q, QKV + row * QW + 2304 + h * 64);
            float mx = -1e30f, l = 0.f;
            for (int s = 0; s <= blk * 64 + 63; ++s) {
                float z; DOT64(z, q, kb + (size_t)s * QW);
                z -= F[s];
                const bool act = s <= t;
                const float mn = act ? fmaxf(mx, z) : mx;
                const float al = expf(mx - mn), p = act ? expf(z - mn) : 0.f;
                mx = mn; l = l * al + p;
#pragma unroll
                for (int d = 0; d < 64; ++d) o[d] *= al;
                AXPY64(o, p, vb + (size_t)s * QW);
            }
            const float il = 1.0f / l;
            STOREO(O + row * DM + 768 + h * 64, o, il);
        } else {
            const int u = wu - 2048; const int c = u >> 6, bh = u & 63, b = bh >> 3, h = bh & 7;
            const int t = c * 64 + lane; const size_t row = (size_t)b * SEQ + t;
            const bf16* kb = QKV + (size_t)b * SEQ * QW + 1280 + h * 64; const bf16* vb = kb + 512;
            LOADQ(q, QKV + row * QW + 768 + h * 64);
            float mx = -1e30f, l = 0.f;
            const int s_lo = c >= 8 ? (c - 8) * 64 : 0;
            for (int s = s_lo; s <= c * 64 + 63; ++s) {
                float z; DOT64(z, q, kb + (size_t)s * QW);
                int rl = t - s; rl = rl > 128 ? 128 : (rl < -128 ? -128 : rl);
                z += rel[(rl + 128) * 8 + h];
                const float mn = fmaxf(mx, z);
                const float al = expf(mx - mn), p = expf(z - mn);
                mx = mn; l = l * al + p;
#pragma unroll
                for (int d = 0; d < 64; ++d) o[d] *= al;
                AXPY64(o, p, vb + (size_t)s * QW);
            }
            const float il = 1.0f / l;
            STOREO(O + row * DM + 256 + h * 64, o, il);
        }
    }
}

namespace att {
typedef short bf16x8 __attribute__((ext_vector_type(8)));
typedef short s16x4 __attribute__((ext_vector_type(4)));
typedef float f32x16 __attribute__((ext_vector_type(16)));
constexpr int WLDS = 17664;
__device__ __forceinline__ int crow(int r, int h) { return (r & 3) + 8 * (r >> 2) + 4 * h; }
__device__ __forceinline__ float xchg32(float v, int lane) { return __int_as_float(__builtin_amdgcn_ds_bpermute((lane ^ 32) << 2, __float_as_int(v))); }
__device__ __forceinline__ float ex2(float v) { return __builtin_amdgcn_exp2f(v); }
__device__ __forceinline__ float lg2(float v) { return __builtin_amdgcn_logf(v); }

__device__ __forceinline__ void load_k(bf16x8 (&k)[2][4], const bf16* kb) {
#pragma unroll
    for (int hf = 0; hf < 2; ++hf)
#pragma unroll
        for (int d0 = 0; d0 < 4; ++d0) k[hf][d0] = *(const bf16x8*)(kb + (size_t)(32 * hf) * QW + 16 * d0);
}
__device__ __forceinline__ void glds16(const void* gsrc, unsigned lds_dst) {
    unsigned keep;
    asm volatile("s_mov_b32 %0, m0\n\ts_mov_b32 m0, %2\n\ts_nop 0\n\tglobal_load_lds_dwordx4 %1, off\n\ts_mov_b32 m0, %0" : "=&s"(keep) : "v"(gsrc), "s"(lds_dst) : "memory");
}
__device__ __forceinline__ void dma_v(LAS unsigned char* vimg, const bf16* vb) {
    const unsigned dst = (unsigned)__builtin_amdgcn_readfirstlane((int)(unsigned)(uintptr_t)vimg);
#pragma unroll
    for (int i = 0; i < 8; ++i) glds16(vb + (size_t)(16 * (i >> 1)) * QW + 32 * (i & 1), dst + (unsigned)((i & 1) * 4096 + (i >> 1) * 1024));
}
__device__ __forceinline__ void wait_v() { asm volatile("s_waitcnt vmcnt(0)" ::: "memory"); }
__device__ __forceinline__ void qk(f32x16 (&S)[2], const bf16x8 (&k)[2][4], const bf16x8 (&q)[4]) {
    __builtin_amdgcn_s_setprio(1);
#pragma unroll
    for (int hf = 0; hf < 2; ++hf) {
        f32x16 acc = S[hf];
#pragma unroll
        for (int d0 = 0; d0 < 4; ++d0) acc = __builtin_amdgcn_mfma_f32_32x32x16_bf16(k[hf][d0], q[d0], acc, 0, 0, 0);
        S[hf] = acc;
    }
    __builtin_amdgcn_s_setprio(0);
}
__device__ __forceinline__ s16x4 vtr(LAS unsigned char* p) {
    typedef short v4i16_t __attribute__((ext_vector_type(4)));
    return __builtin_bit_cast(s16x4, __builtin_amdgcn_ds_read_tr16_b64_v4i16((LAS v4i16_t*)p));
}
__device__ __forceinline__ void pv(f32x16 (&o)[2], LAS unsigned char* vimg, int lane, const f32x16 (&S)[2]) {
    const int h = lane >> 5;
    LAS unsigned char* vb = vimg + (4 * h + ((lane & 15) >> 2)) * 64 + ((lane >> 4) & 1) * 32 + (lane & 3) * 8;
#pragma unroll
    for (int hf = 0; hf < 2; ++hf)
#pragma unroll
        for (int s = 0; s < 2; ++s) {
            v4u pw; pw[0] = pg8::pk_bf16(S[hf][8 * s + 0], S[hf][8 * s + 1]); pw[1] = pg8::pk_bf16(S[hf][8 * s + 2], S[hf][8 * s + 3]);
            pw[2] = pg8::pk_bf16(S[hf][8 * s + 4], S[hf][8 * s + 5]); pw[3] = pg8::pk_bf16(S[hf][8 * s + 6], S[hf][8 * s + 7]);
            const bf16x8 pf = __builtin_bit_cast(bf16x8, pw);
#pragma unroll
            for (int db = 0; db < 2; ++db) {
                LAS unsigned char* p = vb + db * 4096 + (32 * hf + 16 * s) * 64;
                const s16x4 lo = vtr(p), hi = vtr(p + 512);
                const bf16x8 vf = (bf16x8){lo[0], lo[1], lo[2], lo[3], hi[0], hi[1], hi[2], hi[3]};
                o[db] = __builtin_amdgcn_mfma_f32_32x32x16_bf16(vf, pf, o[db], 0, 0, 0);
            }
        }
    asm volatile("" ::: "memory");
}
__device__ __forceinline__ void store_o(bf16* orow  , const f32x16 (&o)[2], float sc, int h) {
#pragma unroll
    for (int db = 0; db < 2; ++db)
#pragma unroll
        for (int g = 0; g < 4; ++g) {
            v2u w; w.x = pg8::pk_bf16(o[db][4 * g] * sc, o[db][4 * g + 1] * sc); w.y = pg8::pk_bf16(o[db][4 * g + 2] * sc, o[db][4 * g + 3] * sc);
            *(v2u*)(orow + 32 * db + 8 * g + 4 * h) = w;
        }
}
template <bool DIAG>
__device__ __forceinline__ void sb_tile(f32x16 (&S)[2], float& R, int kv0, int t, int h, int lane) {
    const int dd = t - kv0 - 4 * h;
    float lf[2][16];
#pragma unroll
    for (int hf = 0; hf < 2; ++hf)
#pragma unroll
        for (int r = 0; r < 16; ++r) {
            const float z = S[hf][r];
            const float sp = fmaxf(z, 0.f) + LN2 * lg2(1.0f + ex2(-LOG2E * fabsf(z)));
            const bool valid = !DIAG || ((32 * hf + (r & 3) + 8 * (r >> 2)) < dd);
            lf[hf][r] = valid ? -sp : 0.f;
        }
    float pg[8], tot[8];
#pragma unroll
    for (int pi = 0; pi < 8; ++pi) { const int hf = pi >> 2, g = pi & 3;
        const float gs = (lf[hf][4 * g] + lf[hf][4 * g + 1]) + (lf[hf][4 * g + 2] + lf[hf][4 * g + 3]);
        pg[pi] = xchg32(gs, lane); tot[pi] = gs + pg[pi]; }
    float suf = R;
#pragma unroll
    for (int pi = 7; pi >= 0; --pi) { const int hf = pi >> 2, g = pi & 3;
        float a = suf + (h == 0 ? pg[pi] : 0.f);
        suf += tot[pi];
#pragma unroll
        for (int e = 3; e >= 0; --e) { const int r = 4 * g + e;
            a += lf[hf][r];
            const bool valid = !DIAG || ((32 * hf + (r & 3) + 8 * (r >> 2)) < dd);
            S[hf][r] = valid ? ex2(LOG2E * (S[hf][r] + a)) : 0.f; }
    }
    R = suf;
}
__device__ __forceinline__ void osm_tile(f32x16 (&S)[2], f32x16 (&o)[2], float& m_run, float& l_run, int lane) {
    float mq[4] = {S[0][0], S[0][1], S[0][2], S[0][3]};
#pragma unroll
    for (int hf = 0; hf < 2; ++hf)
#pragma unroll
        for (int r = 0; r < 16; ++r) mq[r & 3] = fmaxf(mq[r & 3], S[hf][r]);
    float mx = fmaxf(fmaxf(mq[0], mq[1]), fmaxf(mq[2], mq[3]));
    mx = fmaxf(mx, xchg32(mx, lane));
    const bool upd = __any(mx > m_run + 8.0f);
    const float mn = upd ? fmaxf(m_run, mx) : m_run, al = upd ? ex2(m_run - mn) : 1.0f;
    float sq[4] = {0.f, 0.f, 0.f, 0.f};
#pragma unroll
    for (int hf = 0; hf < 2; ++hf)
#pragma unroll
        for (int r = 0; r < 16; ++r) { const float p = ex2(S[hf][r] - mn); S[hf][r] = p; sq[r & 3] += p; }
    const float sum = (sq[0] + sq[1]) + (sq[2] + sq[3]);
    l_run = l_run * al + sum;
    if (upd) {
#pragma unroll
        for (int db = 0; db < 2; ++db)
#pragma unroll
            for (int r = 0; r < 16; ++r) o[db][r] *= al;
    }
    m_run = mn;
}

#ifndef SB_EARLY_EXIT
#define SB_EARLY_EXIT 1
#endif
constexpr float SB_CUT = -110.0f;

template <int MX>
__device__ __forceinline__ void unit_body(const bf16* qp, const bf16* kb, const bf16* vb, bf16* orow, LAS unsigned char* vimg, LAS const float* tab, const float* F,
                                          int ntile, int kv_first, int step, int t, int cdist0  , int lane,
                                          unsigned* ctr, unsigned ngw, unsigned& nidx) {
    const int trig = (MX == 0) ? (ntile > 1 ? 1 : 0) : ntile - 1; bool got = false;
    const int h = lane >> 5;
    f32x16 o[2]; o[0] = f32x16{}; o[1] = f32x16{};
    bf16x8 qf[4], kf[2][4], kn[2][4]; f32x16 S[2];
#pragma unroll
    for (int d0 = 0; d0 < 4; ++d0) qf[d0] = *(const bf16x8*)(qp + 16 * d0);
    dma_v(vimg, vb + (size_t)kv_first * QW);
    load_k(kf, kb + (size_t)kv_first * QW);
    float R = 0.f, m_run = -1e30f, l_run = 0.f;
    f32x4 fk[2][4], fkn[2][4];
    if (MX == 2) {
#pragma unroll
        for (int hf = 0; hf < 2; ++hf)
#pragma unroll
            for (int g = 0; g < 4; ++g) fk[hf][g] = *(const f32x4*)(F + kv_first + 32 * hf + 8 * g + 4 * h);
    }
    for (int j = 0; j < ntile; ++j) {
        if (j == trig) { if (lane == 0) nidx = ngw + atomicAdd(ctr, 1u); got = true; }
        const int kv0 = kv_first + j * step; const bool has_next = j + 1 < ntile;
        LAS unsigned char* vcur = vimg + (j & 1) * 8192; LAS unsigned char* vnext = vimg + ((j & 1) ^ 1) * 8192;
        asm volatile("s_waitcnt lgkmcnt(0)" ::: "memory");
        const int kvn = has_next ? kv0 + step : kv0;
        if (MX == 2) {
#pragma unroll
            for (int hf = 0; hf < 2; ++hf)
#pragma unroll
                for (int r = 0; r < 16; ++r) S[hf][r] = fk[hf][r >> 2][r & 3];
        } else if (MX == 1) {
            if (cdist0 - j >= 3) { const float bc = tab[256];
#pragma unroll
                for (int hf = 0; hf < 2; ++hf)
#pragma unroll
                    for (int r = 0; r < 16; ++r) S[hf][r] = bc;
            } else { const int relb = t - kv0 + 128 - 4 * h;
#pragma unroll
                for (int hf = 0; hf < 2; ++hf)
#pragma unroll
                    for (int r = 0; r < 16; ++r) { int ix = relb - (32 * hf + (r & 3) + 8 * (r >> 2)); ix = ix > 256 ? 256 : ix; S[hf][r] = tab[ix]; }
            }
        } else { S[0] = f32x16{}; S[1] = f32x16{}; }
        qk(S, kf, qf);
        __builtin_amdgcn_sched_barrier(0);
        dma_v(vnext, vb + (size_t)kvn * QW);
        load_k(kn, kb + (size_t)kvn * QW);
        if (MX == 2) {
#pragma unroll
            for (int hf = 0; hf < 2; ++hf)
#pragma unroll
                for (int g = 0; g < 4; ++g) fkn[hf][g] = *(const f32x4*)(F + kvn + 32 * hf + 8 * g + 4 * h);
        }
        __builtin_amdgcn_sched_barrier(0);
        if (MX == 0) {
            if (j == 0) sb_tile<true>(S, R, kv0, t, h, lane); else sb_tile<false>(S, R, kv0, t, h, lane);
        } else if (MX == 2) {
            if (!has_next) {
                const int dd = t - kv0 - 4 * h;
#pragma unroll
                for (int hf = 0; hf < 2; ++hf)
#pragma unroll
                    for (int r = 0; r < 16; ++r) if ((32 * hf + (r & 3) + 8 * (r >> 2)) > dd) S[hf][r] = -1e30f;
            }
            osm_tile(S, o, m_run, l_run, lane);
        } else {
            osm_tile(S, o, m_run, l_run, lane);
        }
        if (MX == 2) asm volatile("s_waitcnt vmcnt(24)" ::: "memory"); else asm volatile("s_waitcnt vmcnt(16)" ::: "memory");
        pv(o, vcur, lane, S);
#if SB_EARLY_EXIT
        if (MX == 0) { if (__all(R < SB_CUT)) break; }
#endif
#pragma unroll
        for (int hf = 0; hf < 2; ++hf)
#pragma unroll
            for (int d0 = 0; d0 < 4; ++d0) kf[hf][d0] = kn[hf][d0];
        if (MX == 2) {
#pragma unroll
            for (int hf = 0; hf < 2; ++hf)
#pragma unroll
                for (int g = 0; g < 4; ++g) fk[hf][g] = fkn[hf][g];
        }
    }
    if (!got) { if (lane == 0) nidx = ngw + atomicAdd(ctr, 1u); }
    asm volatile("s_waitcnt vmcnt(0) lgkmcnt(0)" ::: "memory");
    float sc = 1.0f;
    if (MX != 0) { l_run += xchg32(l_run, lane); sc = 1.0f / l_run; }
    store_o(orow, o, sc, h);
}

__device__ __forceinline__ void attn_mfma(const bf16* QKV, bf16* O, const float* fc, const float* rel, unsigned* ctr, LAS unsigned char* lds, int wave, int lane_in, unsigned mask, unsigned nunits) {
    const unsigned ngw = gridDim.x * NWAVES; bool first = true; unsigned nidx = 0;
    for (;;) {
        int lane = lane_in; asm volatile("" : "+v"(lane));
        LAS unsigned char* vimg = lds + wave * WLDS;
        LAS float* tab = (LAS float*)(vimg + 16384);
        const int r32 = lane & 31, h = lane >> 5;
        unsigned idx = 0;
        if (first) { idx = blockIdx.x * NWAVES + (unsigned)wave; first = false; }
        else idx = __builtin_amdgcn_readfirstlane(nidx);
        if (idx >= nunits) break;
        int mixer, u;
        if (idx < 1664u) { mixer = 2; u = (int)idx; }
        else if (idx < 3712u) { mixer = 0; u = (int)idx - 1664; }
        else if (idx < 4096u) { mixer = 2; u = (int)idx - 2048; }
        else { mixer = 1; u = 0; }
        if (!((mask >> mixer) & 1u)) continue;
        if (mixer != 1) {
            const int qb = 63 - (u >> 5), bh = u & 31, b = bh >> 2, hd = bh & 3;
            const int t0 = 32 * qb, t = t0 + r32, kt_hi = t0 >> 6;
            const int qoff = (mixer == 0 ? 0 : 2304) + 64 * hd, koff = qoff + 256, voff = koff + 256;
            const bf16* base = QKV + (size_t)b * SEQ * QW;
            const bf16* qp = base + (size_t)t * QW + qoff + 8 * h;
            const bf16* kb = base + (size_t)r32 * QW + koff + 8 * h;
            const bf16* vb = base + (size_t)(lane >> 2) * QW + voff + 8 * (lane & 3);
            bf16* orow = O + ((size_t)b * SEQ + t) * DM + (mixer == 0 ? 0 : 768) + 64 * hd;
            if (mixer == 0) unit_body<0>(qp, kb, vb, orow, vimg, tab, nullptr, kt_hi + 1, 64 * kt_hi, -64, t, 0, lane, ctr, ngw, nidx);
            else unit_body<2>(qp, kb, vb, orow, vimg, tab, fc + (size_t)bh * SEQ, kt_hi + 1, 0, 64, t, 0, lane, ctr, ngw, nidx);
        } else {
            const int u = (int)(idx - 4096u), bh = u & 63, rb = u >> 6, b = bh >> 3, hd = bh & 7;
            const int t0 = 32 * rb, t = t0 + r32, c = rb >> 1;
            const bf16* base = QKV + (size_t)b * SEQ * QW;
            const int qoff = 768 + 64 * hd, koff = 1280 + 64 * hd, voff = 1792 + 64 * hd;
            asm volatile("" ::: "memory");
#pragma unroll
            for (int i = 0; i < 5; ++i) { const int j = lane + 64 * i; if (j < NREL) tab[j] = LOG2E * rel[j * 8 + hd]; }
            asm volatile("s_waitcnt lgkmcnt(0)" ::: "memory");
            const bf16* qp = base + (size_t)t * QW + qoff + 8 * h;
            const bf16* kb = base + (size_t)r32 * QW + koff + 8 * h;
            const bf16* vb = base + (size_t)(lane >> 2) * QW + voff + 8 * (lane & 3);
            bf16* orow = O + ((size_t)b * SEQ + t) * DM + 256 + 64 * hd;
            const int kc_lo = c >= 8 ? c - 8 : 0;
            unit_body<1>(qp, kb, vb, orow, vimg, tab, nullptr, c - kc_lo + 1, 64 * kc_lo, 64, t, c - kc_lo, lane, ctr, ngw, nidx);
        }
    }
}

constexpr int CB_D = 3, CB_NBUF = CB_D + 1;
constexpr int CB_TAB = CB_NBUF * 16384, CB_WORD = CB_TAB + 8 * 1280;
__device__ __forceinline__ void attn_b_coop(const bf16* QKV, bf16* O, const float* rel, unsigned* ctr, LAS unsigned char* lds, int wave, int lane_in, int tid) {
    bool first = true;
    for (;;) {
        int lane = lane_in; asm volatile("" : "+v"(lane));
        const int r32 = lane & 31, h = lane >> 5;
        if (tid == 0) { const unsigned uu = first ? blockIdx.x : gridDim.x + atomicAdd(ctr, 1u); *(volatile LAS unsigned*)(lds + CB_WORD) = uu; }
        first = false;
        asm volatile("s_waitcnt vmcnt(0) lgkmcnt(0)\n\ts_barrier" ::: "memory");
        const unsigned u = (unsigned)__builtin_amdgcn_readfirstlane((int)*(volatile LAS unsigned*)(lds + CB_WORD));
        if (u >= 512u) break;
        const int bh = (int)(u & 63u), grp = 7 - (int)(u >> 6), b = bh >> 3, hd = bh & 7;
        const int c0 = 4 * grp, c = c0 + (wave >> 1), rb = 2 * c + (wave & 1), t = 32 * rb + r32;
        const int kc_lo = c0 >= 8 ? c0 - 8 : 0, ntile = c0 + 3 - kc_lo + 1;
        const int my_lo = c >= 8 ? c - 8 : 0;
        const bf16* base = QKV + (size_t)b * SEQ * QW;
        const bf16* ksrc = base + (size_t)(64 * kc_lo + 32 * (wave >> 2) + r32) * QW + 1280 + 64 * hd + 16 * (wave & 3) + 8 * h;
        const bf16* vsrc = base + (size_t)(64 * kc_lo + 16 * (wave >> 1) + (lane >> 2)) * QW + 1792 + 64 * hd + 32 * (wave & 1) + 8 * (lane & 3);
        const unsigned lds0 = (unsigned)__builtin_amdgcn_readfirstlane((int)(unsigned)(uintptr_t)lds);
        const unsigned kdst = lds0 + (unsigned)wave * 1024u, vdst = lds0 + 8192u + (unsigned)((wave & 1) * 4096 + (wave >> 1) * 1024);
#define CB_ISSUE(jj) do { const int jc_ = (jj) < ntile ? (jj) : ntile - 1; const unsigned bo_ = (unsigned)((jj) % CB_NBUF) * 16384u; \
        glds16(ksrc + (size_t)(64 * jc_) * QW, kdst + bo_); glds16(vsrc + (size_t)(64 * jc_) * QW, vdst + bo_); } while (0)
#pragma unroll
        for (int jj = 0; jj < CB_D; ++jj) CB_ISSUE(jj);
        const bf16* qp = base + (size_t)t * QW + 768 + 64 * hd + 8 * h;
        bf16x8 qf[4];
#pragma unroll
        for (int d0 = 0; d0 < 4; ++d0) qf[d0] = *(const bf16x8*)(qp + 16 * d0);
        LAS float* tab = (LAS float*)(lds + CB_TAB + wave * 1280);
#pragma unroll
        for (int i = 0; i < 5; ++i) { const int j = lane + 64 * i; if (j < NREL) tab[j] = LOG2E * rel[j * 8 + hd]; }
        asm volatile("s_waitcnt vmcnt(0)" :: "v"(qf[0]), "v"(qf[1]), "v"(qf[2]), "v"(qf[3]) : "memory");
        f32x16 o[2]; o[0] = f32x16{}; o[1] = f32x16{};
        float m_run = -1e30f, l_run = 0.f;
        for (int j = 0; j < ntile; ++j) {
            const int kc = kc_lo + j, kv0 = 64 * kc;
            const unsigned bo = (unsigned)(j % CB_NBUF) * 16384u;
            asm volatile("s_waitcnt vmcnt(4) lgkmcnt(0)\n\ts_barrier" ::: "memory");
            CB_ISSUE(j + CB_D);
            if (kc >= my_lo && kc <= c) {
                LAS unsigned char* kimg = lds + bo; LAS unsigned char* vimg = lds + bo + 8192;
                bf16x8 kf[2][4]; f32x16 S[2];
#pragma unroll
                for (int hf = 0; hf < 2; ++hf)
#pragma unroll
                    for (int d0 = 0; d0 < 4; ++d0) kf[hf][d0] = *(const LAS bf16x8*)(kimg + (hf * 4 + d0) * 1024 + 16 * lane);
                if (c - kc >= 3) {
                    const float bc = tab[256];
#pragma unroll
                    for (int hf = 0; hf < 2; ++hf)
#pragma unroll
                        for (int r = 0; r < 16; ++r) S[hf][r] = bc;
                } else {
                    const int relb = t - kv0 + 128 - 4 * h;
#pragma unroll
                    for (int hf = 0; hf < 2; ++hf)
#pragma unroll
                        for (int r = 0; r < 16; ++r) { int ix = relb - (32 * hf + (r & 3) + 8 * (r >> 2)); ix = ix > 256 ? 256 : ix; S[hf][r] = tab[ix]; }
                }
                qk(S, kf, qf);
                osm_tile(S, o, m_run, l_run, lane);
                pv(o, vimg, lane, S);
            }
        }
#undef CB_ISSUE
        l_run += xchg32(l_run, lane);
        store_o(O + ((size_t)b * SEQ + t) * DM + 256 + 64 * hd, o, 1.0f / l_run, h);
    }
}
}

#define XB_TMO      128
#define XB_XCNT(j)  (256  + 64 * (j))
#define XB_XSUB(j)  (1280 + 64 * (j))
#define XB_XGEN(j)  (2304 + 64 * (j))
#define XB_TOP      3328
#define XB_TOPGEN   3392
#define XCD_BAR_WORDS 3456
#define XB_SPIN_CAP (1u << 18)
__device__ __forceinline__ unsigned xb_ld(unsigned* p)              { return __hip_atomic_load(p, __ATOMIC_RELAXED, __HIP_MEMORY_SCOPE_AGENT); }
__device__ __forceinline__ unsigned xb_add(unsigned* p, unsigned v) { return __hip_atomic_fetch_add(p, v, __ATOMIC_RELAXED, __HIP_MEMORY_SCOPE_AGENT); }
__device__ __forceinline__ unsigned xb_xcc_id() { return (unsigned)__builtin_amdgcn_s_getreg((3 << 11) | 20) & 0xFu; }
#define XB_SPIN(cond, bar) do { unsigned _sp = 0; while (cond) { __builtin_amdgcn_s_sleep(1); \
    if ((++_sp & 255u) == 0u) { if (xb_ld(&(bar)[XB_TMO])) break; if (_sp > XB_SPIN_CAP) { atomicAdd(&(bar)[XB_TMO], 1u); break; } } } } while (0)
struct XcdBarrier { unsigned* bar; unsigned x; volatile LAS unsigned* st; };
__device__ __forceinline__ XcdBarrier xcd_barrier_post(unsigned* bar, volatile LAS unsigned* st) {
    XcdBarrier b; b.bar = bar; b.x = xb_xcc_id(); b.st = st;
    if (threadIdx.x == 0) (void)xb_add(&bar[XB_XCNT(b.x)], 1u);
    return b;
}
__device__ __forceinline__ void xcd_barrier_complete(unsigned* bar, unsigned x, unsigned& nloc, unsigned& nx) {
    const unsigned G = gridDim.x * gridDim.y * gridDim.z;
    unsigned sum, cnt, mine, sp = 0u;
    for (;;) {
        sum = 0u; cnt = 0u; mine = 0u;
#pragma unroll
        for (unsigned j = 0; j < 16; ++j) { const unsigned c = xb_ld(&bar[XB_XCNT(j)]); sum += c; cnt += (c > 0u) ? 1u : 0u; mine = (j == x) ? c : mine; }
        if (sum == G) break;
        __builtin_amdgcn_s_sleep(1);
        if ((++sp & 255u) == 0u) { if (xb_ld(&bar[XB_TMO])) break; if (sp > XB_SPIN_CAP) { atomicAdd(&bar[XB_TMO], 1u); break; } }
    }
    nloc = mine > 0u ? mine : 1u; nx = cnt > 0u ? cnt : 1u;
}
__device__ __forceinline__ void xcd_barrier(const XcdBarrier& b) {
    asm volatile("s_waitcnt vmcnt(0)" ::: "memory");
    __syncthreads();
    if (threadIdx.x == 0) {
        unsigned* bar = b.bar;
        __builtin_amdgcn_s_waitcnt(0);
        unsigned nloc = b.st[0], nx = b.st[1];
        if (nloc == 0u) { xcd_barrier_complete(bar, b.x, nloc, nx); b.st[0] = nloc; b.st[1] = nx; }
        const unsigned old = xb_add(&bar[XB_XSUB(b.x)], 1u);
        const unsigned gen = old / nloc;
        if (old + 1u == (gen + 1u) * nloc) {
            __builtin_amdgcn_fence(__ATOMIC_RELEASE, "agent");
            asm volatile("s_waitcnt vmcnt(0)" ::: "memory");
            const unsigned og = xb_add(&bar[XB_TOP], 1u);
            const unsigned tg = og / nx;
            if (og + 1u == (tg + 1u) * nx) xb_add(&bar[XB_TOPGEN], 1u);
            else XB_SPIN(xb_ld(&bar[XB_TOPGEN]) == tg, bar);
            __builtin_amdgcn_fence(__ATOMIC_ACQUIRE, "agent");
            xb_add(&bar[XB_XGEN(b.x)], 1u);
            asm volatile("s_waitcnt vmcnt(0)" ::: "memory");
        } else {
            XB_SPIN(xb_ld(&bar[XB_XGEN(b.x)]) == gen, bar);
            __builtin_amdgcn_fence(__ATOMIC_ACQUIRE, "agent");
            asm volatile("s_waitcnt vmcnt(0)" ::: "memory");
        }
    }
    __syncthreads();
}

constexpr int N_PHASES = 17;

__global__ void __launch_bounds__(NWAVES * 64, 2) mk_fwd(Args a) {
    extern __shared__ __attribute__((aligned(16))) unsigned char lds_raw[];
    LAS unsigned char* lds = (LAS unsigned char*)lds_raw;
    const int G = gridDim.x, bx = blockIdx.x, NGW = G * NWAVES;
    { LAS unsigned long long* tab = (LAS unsigned long long*)(lds + PTAB_OFF); const int t0 = threadIdx.x;
      if (t0 < 16) tab[t0] = (unsigned long long)a.in[t0];
      if (t0 == 16) tab[16] = (unsigned long long)a.out;
      if (t0 == 17) tab[17] = (unsigned long long)a.ws;
      if (t0 == 18) { ((LAS unsigned*)(lds + PTAB_OFF + 192))[0] = 0u; ((LAS unsigned*)(lds + PTAB_OFF + 192))[1] = 0u; } }
    __syncthreads();
    const XcdBarrier xbar = xcd_barrier_post((unsigned*)(a.ws + WS_CTL) + CW_BAR, (volatile LAS unsigned*)(lds + PTAB_OFF + 192));
    if (a.ph_lo < 0) cg::this_grid().sync();
    const int ph_lo = a.ph_lo, ph_hi = a.ph_hi;
#define PTR(i) ((const float*)(GAS_ const float*)ld_ptr(lds, (i)))
#define PH_BEGIN \
        int tid_ = threadIdx.x; asm volatile("" : "+v"(tid_)); \
        const int tid = tid_, lane = tid & 63, wave = __builtin_amdgcn_readfirstlane(tid >> 6); \
        const int gw = bx * NWAVES + wave; (void)gw; (void)lane; \
        LAS float* scr = (LAS float*)(lds + wave * 16384); (void)scr; \
        unsigned char* ws = (unsigned char*)(GAS_ unsigned char*)ld_ptr(lds, 17); \
        float* X = (float*)(GAS_ float*)ld_ptr(lds, 16); (void)X; \
        bf16* XN = (bf16*)(ws + WS_XN); bf16* QKV = (bf16*)(ws + WS_R1); bf16* GT = (bf16*)(ws + WS_R2); bf16* HB = (bf16*)(ws + WS_R2); \
        bf16* MG = (bf16*)(ws + WS_MERGED); float* TB = (float*)(ws + WS_T); float* PART = (float*)(ws + WS_PART); float* PARTD = (float*)(ws + WS_PARTD); float* FC = (float*)(ws + WS_FC); \
        (void)XN; (void)QKV; (void)GT; (void)HB; (void)MG; (void)TB; (void)PART; (void)PARTD; (void)FC;
#define IN(k) (ph_lo <= (k) && (k) < ph_hi)
#define SEAM(k) do { if (IN(k) && IN((k) + 1)) xcd_barrier(xbar); } while (0)

    if (IN(0)) { PH_BEGIN
        conv_ffn(lds, ws, 0, 0, 0, scr, gw, NGW, lane, 1);
        rows_raw(PTR(0), XN, PART, gw, NGW, lane);
    }
    SEAM(0);
#define LAYER(L, P0) \
    if (IN(P0)) { PH_BEGIN const bf16* w = (const bf16*)(ws + WS_T + (size_t)(L == 0 ? 0 : 2) * FFN_SLOT); \
        pg8::Gemm g{XN, w}; pg8::StaticOrder S; S.init(M, 2 * DFF, G, bx); pg8::EpiSwiglu E{HB, DFF, PART}; \
        for (int rep = 0; rep <= PROBE_G1; ++rep) pg8::gemm_phase<pg8::EpiSwiglu, pg8::StaticOrder, DM, DM, DM>(lds, g, S, E); \
        {     \
            const int nidle = G - (1408 % G); \
            if (1408 % G != 0 && bx >= 1408 % G) { if (L == 0) conv_ffn(lds, ws, 0, 0, 0, scr, (bx - 1408 % G) * NWAVES + wave, nidle * NWAVES, lane, 2); \
                                                    conv_mix(lds, ws, L, scr, (bx - 1408 % G) * NWAVES + wave, nidle * NWAVES, lane, L == 0 ? 1408 : 0); } \
            else if (1408 % G == 0) { if (L == 0) conv_ffn(lds, ws, 0, 0, 0, scr, gw, NGW, lane, 2); conv_mix(lds, ws, L, scr, gw, NGW, lane, L == 0 ? 1408 : 0); } } } \
    SEAM(P0); \
    if (IN(P0 + 1)) { PH_BEGIN const bf16* w = (const bf16*)(ws + WS_T + (size_t)(L == 0 ? 0 : 2) * FFN_SLOT + FFN_SLOT_OUT); \
        pg8::Gemm g{HB, w}; pg8::StaticOrder S; S.init(M, DM, G, bx); \
        pg8::EpiResid E{XN, X, XN, PART, PARTD, PTR(5) + (size_t)L * DM * INW, PTR(4) + L * DM, nullptr, nullptr, 0.5f}; \
        pg8::gemm_phase<pg8::EpiResid, pg8::StaticOrder, DFF, DFF, DFF>(lds, g, S, E); } \
    SEAM(P0 + 1); \
    if (IN(P0 + 2)) { PH_BEGIN if (bx < 32) cumsum_seq(PART, PARTD, PTR(6) + L * INW + QW, FC, bx, (LAS float*)lds, tid); \
        const bf16* w = (const bf16*)(ws + WS_WMIX + (size_t)L * WMIX_LAYER); \
        pg8::Gemm g{XN, w}; pg8::StaticOrder S; S.init(M, 2 * QW, G, bx); pg8::EpiQKVG E{QKV, GT, PTR(6) + L * INW, PART}; \
        pg8::gemm_phase<pg8::EpiQKVG, pg8::StaticOrder, DM, DM, DM>(lds, g, S, E); } \
    SEAM(P0 + 2); \
    if (IN(P0 + 3)) { PH_BEGIN \
        att::attn_b_coop(QKV, (bf16*)X, PTR(7) + L * NREL * 8, (unsigned*)(ws + WS_CTL) + 4 + L, lds, wave, lane, tid); \
        if (PROBE_ATT == 1) att::attn_b_coop(QKV, (bf16*)X, PTR(7) + L * NREL * 8, (unsigned*)(ws + WS_CTL) + 6 + L, lds, wave, lane, tid); \
        att::attn_mfma(QKV, (bf16*)X, FC, PTR(7) + L * NREL * 8, (unsigned*)(ws + WS_CTL) + L, lds, wave, lane, 5u, 4096u); \
        if (PROBE_ATT == 2) att::attn_mfma(QKV, (bf16*)X, FC, PTR(7) + L * NREL * 8, (unsigned*)(ws + WS_CTL) + 2 + L, lds, wave, lane, 5u, 4096u); \
        if (PROBE_ATT == 3) att::attn_mfma(QKV, (bf16*)X, FC, PTR(7) + L * NREL * 8, (unsigned*)(ws + WS_CTL) + 2 + L, lds, wave, lane, 1u, 2048u); \
        if (7u & ~MFMA_MASK) attn_naive(QKV, (bf16*)X, FC, PTR(7) + L * NREL * 8, gw, NGW, lane, 7u & ~MFMA_MASK); } \
    SEAM(P0 + 3); \
    if (IN(P0 + 4)) { PH_BEGIN const bf16* w = (const bf16*)(ws + WS_WMIX + (size_t)L * WMIX_LAYER + WMIX_BR); \
        pg8::StaticOrder S; S.init(M, DM, G, bx); \
        { pg8::Gemm g{(const bf16*)X, w}; pg8::EpiBranch1 E{GT, MG}; pg8::gemm_phase<pg8::EpiBranch1, pg8::StaticOrder, DM, DM, DM>(lds, g, S, E); } } \
    SEAM(P0 + 4); \
    if (IN(P0 + 5)) { PH_BEGIN \
        if (L == 0) conv_ffn(lds, ws, 0, 1, 1, scr, gw, NGW, lane); \
        else conv_ffn(lds, ws, 1, 1, 0, scr, gw, NGW, lane, 1); \
        __syncthreads(); \
        const bf16* w = (const bf16*)(ws + WS_WMIX + (size_t)L * WMIX_LAYER + WMIX_OUT); \
        pg8::Gemm g{MG, w}; pg8::StaticOrder S; S.init(M, DM, G, bx); pg8::EpiResid E{XN, X, XN, PART, nullptr, nullptr, nullptr, nullptr, nullptr, 1.0f}; \
        pg8::gemm_phase<pg8::EpiResid, pg8::StaticOrder, DM, DM, DM>(lds, g, S, E); } \
    SEAM(P0 + 5); \
    if (IN(P0 + 6)) { PH_BEGIN const bf16* w = (const bf16*)(ws + WS_T + (size_t)(L == 0 ? 1 : 0) * FFN_SLOT); \
        pg8::Gemm g{XN, w}; pg8::StaticOrder S; S.init(M, 2 * DFF, G, bx); pg8::EpiSwiglu E{HB, DFF, PART}; \
        pg8::gemm_phase<pg8::EpiSwiglu, pg8::StaticOrder, DM, DM, DM>(lds, g, S, E); \
        if (L == 0) {     \
            const int nidle = G - (1408 % G); \
            if (1408 % G != 0 && bx >= 1408 % G) conv_ffn(lds, ws, 1, 0, 2, scr, (bx - 1408 % G) * NWAVES + wave, nidle * NWAVES, lane); \
            else if (1408 % G == 0) conv_ffn(lds, ws, 1, 0, 2, scr, gw, NGW, lane); } \
        else {     \
            const int nidle = G - (1408 % G); \
            if (1408 % G != 0 && bx >= 1408 % G) conv_ffn(lds, ws, 1, 1, 0, scr, (bx - 1408 % G) * NWAVES + wave, nidle * NWAVES, lane, 2); \
            else if (1408 % G == 0) conv_ffn(lds, ws, 1, 1, 0, scr, gw, NGW, lane, 2); } } \
    SEAM(P0 + 6); \
    if (IN(P0 + 7)) { PH_BEGIN const bf16* w = (const bf16*)(ws + WS_T + (size_t)(L == 0 ? 1 : 0) * FFN_SLOT + FFN_SLOT_OUT); \
        pg8::Gemm g{HB, w}; pg8::StaticOrder S; S.init(M, DM, G, bx); pg8::EpiResid E{XN, X, L == 1 ? nullptr : XN, PART, nullptr, nullptr, nullptr, L == 1 ? PTR(15) : nullptr, (unsigned*)(ws + WS_CTL) + CW_PANEL, 0.5f}; \
        pg8::gemm_phase<pg8::EpiResid, pg8::StaticOrder, DFF, DFF, DFF>(lds, g, S, E); } \
    SEAM(P0 + 7);

    LAYER(0, 1)
    LAYER(1, 9)
    for (int rep = 0; rep < PROBE_SYNC; ++rep) xcd_barrier(xbar);
}

extern "C" void kernel_launch(void* const* d_in, const int* in_sizes, int n_in, void* d_out, int out_size, void* d_ws, size_t ws_size, hipStream_t stream) {
    static int grid = 0;
    if (grid == 0) {
        if (n_in != 16 || out_size != M * DM || ws_size < WS_END) { fprintf(stderr, "kernel_launch: unexpected shapes (n_in %d out %d ws %zu)\n", n_in, out_size, ws_size); grid = -1; return; }
        int dev = 0, cus = 0, per_cu = 0;
        (void)hipGetDevice(&dev);
        (void)hipDeviceGetAttribute(&cus, hipDeviceAttributeMultiprocessorCount, dev);
        (void)hipFuncSetAttribute((const void*)mk_fwd, hipFuncAttributeMaxDynamicSharedMemorySize, LDS_BYTES);
        (void)hipOccupancyMaxActiveBlocksPerMultiprocessor(&per_cu, (const void*)mk_fwd, NWAVES * 64, LDS_BYTES);
        if (per_cu < 1) per_cu = 1;
        grid = cus * per_cu;
        if (grid > 256) grid = 256;
        (void)hipGetLastError();
    }
    if (grid < 0) return;
    (void)hipMemsetAsync((char*)d_ws + WS_CTL, 0, 64 * 1024, stream);
    Args a{};
    for (int i = 0; i < 16; ++i) a.in[i] = (const float*)d_in[i];
    a.out = (float*)d_out; a.ws = (unsigned char*)d_ws;
#if MULTI_LAUNCH
    for (int ph = 0; ph < N_PHASES; ++ph) { a.ph_lo = ph; a.ph_hi = ph + 1; hipLaunchKernelGGL(mk_fwd, dim3(grid), dim3(NWAVES * 64), LDS_BYTES, stream, a); }
#else
    a.ph_lo = 0; a.ph_hi = N_PHASES;
    void* args[] = {&a};
    hipError_t e = hipLaunchCooperativeKernel((const void*)mk_fwd, dim3(grid), dim3(NWAVES * 64), args, LDS_BYTES, stream);
    if (e != hipSuccess) fprintf(stderr, "cooperative launch failed: %s (grid %d)\n", hipGetErrorString(e), grid);
#endif
}
```

```cpp
#include <hip/hip_runtime.h>
#include <hip/hip_cooperative_groups.h>
#include <cstdio>
#include <cstdint>
namespace cg = cooperative_groups;

#ifndef MFMA_MASK
#define MFMA_MASK 7u
#endif
#ifndef PROBE_ATT
#define PROBE_ATT 0
#endif
#ifndef PROBE_G1
#define PROBE_G1 0
#endif
#ifndef PROBE_SYNC
#define PROBE_SYNC 0
#endif
#ifndef MULTI_LAUNCH
#define MULTI_LAUNCH 0
#endif

namespace pg8 {
#define PG8_LAS __attribute__((address_space(3)))
typedef unsigned short bf16_t;
typedef short bf16x8 __attribute__((ext_vector_type(8)));
typedef float f32x4 __attribute__((ext_vector_type(4)));
typedef unsigned u32x4 __attribute__((ext_vector_type(4)));
typedef unsigned u32x2 __attribute__((ext_vector_type(2)));
constexpr int BM = 256, BK = 64, HALF = 128, HTB = HALF * BK * 2, STAGE_BYTES = 8 * HTB, NXCD = 8, WGM = 8;

__host__ __device__ __forceinline__ int lds_byte(int r, int c) { const int st = (r >> 4) * 2 + (c >> 5), rr = r & 15, cc = c & 31, ob = rr * 64 + cc * 2; return st * 1024 + (ob ^ (((ob >> 9) & 1) << 5)); }
__host__ __device__ __forceinline__ void stage_rc(int b, int& R, int& C) { const int st = b / 1024, sb = b % 1024, swz = sb ^ (((sb >> 9) & 1) << 5); R = (st >> 1) * 16 + swz / 64; C = (st & 1) * 32 + (swz % 64) / 2; }
__host__ __device__ __forceinline__ int perm32(int rho) { const int n = rho >> 4, i = rho & 15; return 8 * (i >> 2) + 4 * n + (i & 3); }

struct Unit { int pm, pn; };
struct Gemm { const bf16_t* A; const bf16_t* Bt; };

struct StaticOrder {
    int nM, nN, nwg, G, c;
    __host__ __device__ void init(int M, int N, int G_, int c_) { nM = M / BM; nN = N / BM; nwg = nM * nN; G = G_; c = c_; }
    __host__ __device__ bool next(int i, Unit& u) const {
        const long L = (long)i * G + c; if (L >= nwg) return false;
        int wgid = (int)L; { const int q = nwg / NXCD, r = nwg % NXCD, xcd = wgid % NXCD, off = wgid / NXCD; wgid = (xcd < r ? xcd * (q + 1) : r * (q + 1) + (xcd - r) * q) + off; }
        const int nig = WGM * nN, gid = wgid / nig, fm = gid * WGM, gsz = (nM - fm) < WGM ? (nM - fm) : WGM;
        u.pm = fm + ((wgid % nig) % gsz); u.pn = (wgid % nig) / gsz; return true;
    }
};

__device__ __forceinline__ unsigned pk_bf16(float lo, float hi) {
    typedef float f2 __attribute__((ext_vector_type(2))); typedef __bf16 b2 __attribute__((ext_vector_type(2)));
    f2 v = {lo, hi}; b2 b = __builtin_convertvector(v, b2); return __builtin_bit_cast(unsigned, b);
}
__device__ __forceinline__ float bf_lo(unsigned w) { return __uint_as_float(w << 16); }
__device__ __forceinline__ float bf_hi(unsigned w) { return __uint_as_float(w & 0xffff0000u); }
__device__ __forceinline__ float fast_sigmoid(float v) { return __builtin_amdgcn_rcpf(1.0f + __builtin_amdgcn_exp2f(-1.4426950408889634f * v)); }

constexpr int MROWS = 16384;
__device__ __forceinline__ float row_rstd(const float* part, int row) {
    const float ss = (part[row] + part[MROWS + row]) + (part[2 * MROWS + row] + part[3 * MROWS + row]);
    return 1.0f / sqrtf(ss * (1.0f / 1024.0f) + 1e-6f);
}
struct EpiSwiglu {
    static constexpr bool PERM = true, AFTER_DRAIN = false, RSTD = true, RESCALE = false, BIAS = false;
    bf16_t* H; int ldh; const float* part;
    __device__ __forceinline__ void operator()(const f32x4 (&acc)[2][2][4][2], const Unit& u, int wr, int wc, int fr, int fq, const PG8_LAS float* rsl) const {
        const int row0 = u.pm * BM + wr * 64 + fr, col0 = u.pn * HALF + wc * 32 + 8 * fq;
#pragma unroll
        for (int ai = 0; ai < 2; ++ai)
#pragma unroll
            for (int m = 0; m < 4; ++m) {
                bf16_t* p = H + (size_t)(row0 + ai * HALF + m * 16) * ldh + col0;
                const float rs = rsl[ai * HALF + wr * 64 + m * 16 + fr];
                float h[8];
#pragma unroll
                for (int n = 0; n < 2; ++n)
#pragma unroll
                    for (int e = 0; e < 4; ++e) { const float g = rs * acc[ai][0][m][n][e], up = rs * acc[ai][1][m][n][e]; h[n * 4 + e] = g * fast_sigmoid(g) * up; }
                u32x4 w; w.x = pk_bf16(h[0], h[1]); w.y = pk_bf16(h[2], h[3]); w.z = pk_bf16(h[4], h[5]); w.w = pk_bf16(h[6], h[7]);
                *(u32x4*)p = w;
            }
    }
};
struct EpiResid {
    static constexpr bool PERM = true, AFTER_DRAIN = true, RSTD = false, RESCALE = false;
    const bf16_t* base; float* out; bf16_t* xb; float* part; float* partd; const float* wf; const float* gmix; const float* gfin; unsigned* cnt; float scale;
    __device__ __forceinline__ void fused(f32x4 (&acc)[2][2][4][2], const Unit& u, int wr, int wc, int fr, int fq, PG8_LAS unsigned char* lds, int tid) const {
        const int row0 = u.pm * BM + wr * 64 + fr, col0 = u.pn * BM + wc * 32 + 8 * fq;
#pragma unroll
        for (int ai = 0; ai < 2; ++ai)
#pragma unroll
            for (int m = 0; m < 4; ++m) {
                const size_t off = (size_t)(row0 + ai * HALF + m * 16) * 1024 + col0;
#pragma unroll
                for (int bj = 0; bj < 2; ++bj) {
                    const u32x4 bw = *(const u32x4*)(base + off + bj * HALF);
                    const f32x4 b0 = {bf_lo(bw.x), bf_hi(bw.x), bf_lo(bw.y), bf_hi(bw.y)}, b1 = {bf_lo(bw.z), bf_hi(bw.z), bf_lo(bw.w), bf_hi(bw.w)};
                    const f32x4 v0 = b0 + acc[ai][bj][m][0] * scale, v1 = b1 + acc[ai][bj][m][1] * scale;
                    if (xb) { u32x4 w; w.x = pk_bf16(v0[0], v0[1]); w.y = pk_bf16(v0[2], v0[3]); w.z = pk_bf16(v1[0], v1[1]); w.w = pk_bf16(v1[2], v1[3]);
                              *(u32x4*)(xb + off + bj * HALF) = w; }
                    acc[ai][bj][m][0] = v0; acc[ai][bj][m][1] = v1;
                }
                asm volatile("" ::: "memory");
            }
        if (!xb && !gfin) return;
        float ss[8], dd[8][4];
#pragma unroll
        for (int r = 0; r < 8; ++r) { ss[r] = 0.f; dd[r][0] = 0.f; dd[r][1] = 0.f; dd[r][2] = 0.f; dd[r][3] = 0.f; }
#pragma unroll
        for (int ai = 0; ai < 2; ++ai)
#pragma unroll
            for (int m = 0; m < 4; ++m)
#pragma unroll
                for (int bj = 0; bj < 2; ++bj)
#pragma unroll
                    for (int n = 0; n < 2; ++n) { const f32x4 v = acc[ai][bj][m][n]; ss[ai * 4 + m] += (v[0] * v[0] + v[1] * v[1]) + (v[2] * v[2] + v[3] * v[3]); }
        if (partd) {
#pragma unroll
            for (int bj = 0; bj < 2; ++bj)
#pragma unroll
                for (int n = 0; n < 2; ++n) {
#pragma unroll
                    for (int e = 0; e < 4; ++e) {
                        const int c = col0 + bj * HALF + 4 * n + e;
                        const f32x4 w4 = *(const f32x4*)(wf + (size_t)c * 6148 + 3072) * gmix[c];
#pragma unroll
                        for (int ai = 0; ai < 2; ++ai)
#pragma unroll
                            for (int m = 0; m < 4; ++m) { const float x = acc[ai][bj][m][n][e];
                                dd[ai * 4 + m][0] += x * w4[0]; dd[ai * 4 + m][1] += x * w4[1]; dd[ai * 4 + m][2] += x * w4[2]; dd[ai * 4 + m][3] += x * w4[3]; }
                    }
                    asm volatile("" ::: "memory");
                }
        }
        const int lane = tid & 63;
        PG8_LAS float* red = (PG8_LAS float*)lds;
#pragma unroll
        for (int r = 0; r < 8; ++r) {
            float v = ss[r];
            v += __int_as_float(__builtin_amdgcn_ds_bpermute((lane ^ 16) << 2, __float_as_int(v)));
            v += __int_as_float(__builtin_amdgcn_ds_bpermute((lane ^ 32) << 2, __float_as_int(v)));
            const int rl = (r >> 2) * HALF + wr * 64 + (r & 3) * 16 + fr;
            if (fq == 0) red[(rl * 4 + wc) * 5] = v;
            if (partd) {
#pragma unroll
                for (int hh = 0; hh < 4; ++hh) {
                    float d = dd[r][hh];
                    d += __int_as_float(__builtin_amdgcn_ds_bpermute((lane ^ 16) << 2, __float_as_int(d)));
                    d += __int_as_float(__builtin_amdgcn_ds_bpermute((lane ^ 32) << 2, __float_as_int(d)));
                    if (fq == 0) red[(rl * 4 + wc) * 5 + 1 + hh] = d;
                }
            }
        }
        asm volatile("s_waitcnt lgkmcnt(0)" ::: "memory"); __builtin_amdgcn_s_barrier(); asm volatile("" ::: "memory");
        if (gfin) {
            if (tid < 256) { const PG8_LAS float* rp = red + tid * 20; const int gm = u.pm * BM + tid;
                __hip_atomic_store(part + (size_t)u.pn * MROWS + gm, (rp[0] + rp[5]) + (rp[10] + rp[15]), __ATOMIC_RELAXED, __HIP_MEMORY_SCOPE_AGENT); }
            asm volatile("s_waitcnt vmcnt(0)" ::: "memory"); __builtin_amdgcn_s_barrier(); asm volatile("" ::: "memory");
            if (tid == 0) {
                __hip_atomic_fetch_add(cnt + 64 * u.pm, 1u, __ATOMIC_RELAXED, __HIP_MEMORY_SCOPE_AGENT);
                unsigned spins = 0;
                while (__hip_atomic_load(cnt + 64 * u.pm, __ATOMIC_RELAXED, __HIP_MEMORY_SCOPE_AGENT) < 4u) { __builtin_amdgcn_s_sleep(2); if (++spins > (1u << 22)) break; }
                __builtin_amdgcn_fence(__ATOMIC_ACQUIRE, "agent");
            }
            asm volatile("s_waitcnt vmcnt(0) lgkmcnt(0)" ::: "memory"); __builtin_amdgcn_s_barrier(); asm volatile("" ::: "memory");
            PG8_LAS float* rsf = red + 256 * 20;
            if (tid < 256) { const int gm = u.pm * BM + tid; float ssum = 0.f;
#pragma unroll
                for (int p4 = 0; p4 < 4; ++p4) ssum += __hip_atomic_load(part + (size_t)p4 * MROWS + gm, __ATOMIC_RELAXED, __HIP_MEMORY_SCOPE_AGENT);
                rsf[tid] = 1.0f / sqrtf(ssum * (1.0f / 1024.0f) + 1e-6f); }
            asm volatile("s_waitcnt vmcnt(0) lgkmcnt(0)" ::: "memory"); __builtin_amdgcn_s_barrier(); asm volatile("" ::: "memory");
            f32x4 gv[2][2];
#pragma unroll
            for (int bj = 0; bj < 2; ++bj)
#pragma unroll
                for (int n = 0; n < 2; ++n) gv[bj][n] = *(const f32x4*)(gfin + col0 + bj * HALF + 4 * n);
#pragma unroll
            for (int ai = 0; ai < 2; ++ai)
#pragma unroll
                for (int m = 0; m < 4; ++m) {
                    const float rs = rsf[ai * HALF + wr * 64 + m * 16 + fr];
                    const size_t off = (size_t)(row0 + ai * HALF + m * 16) * 1024 + col0;
#pragma unroll
                    for (int bj = 0; bj < 2; ++bj) {
                        *(f32x4*)(out + off + bj * HALF) = acc[ai][bj][m][0] * rs * gv[bj][0];
                        *(f32x4*)(out + off + bj * HALF + 4) = acc[ai][bj][m][1] * rs * gv[bj][1];
                    }
                }
            return;
        }
        if (tid < 256) {
            const PG8_LAS float* rp = red + tid * 20; const int gm = u.pm * BM + tid;
            part[(size_t)u.pn * MROWS + gm] = (rp[0] + rp[5]) + (rp[10] + rp[15]);
            if (partd) { f32x4 o;
#pragma unroll
                for (int hh = 0; hh < 4; ++hh) o[hh] = (rp[1 + hh] + rp[6 + hh]) + (rp[11 + hh] + rp[16 + hh]);
                *(f32x4*)(partd + ((size_t)u.pn * MROWS + gm) * 4) = o; }
        }
    }
};
struct EpiQKVG {
    static constexpr bool PERM = true, AFTER_DRAIN = false, RSTD = true, RESCALE = false, BIAS = true;
    bf16_t* QKV; bf16_t* G; const float* bias; const float* part;
    __device__ __forceinline__ void operator()(const f32x4 (&acc)[2][2][4][2], const Unit& u, int wr, int wc, int fr, int fq, const PG8_LAS float* rsl) const {
        const int row0 = u.pm * BM + wr * 64 + fr;
        const bool gate = u.pn >= 12;
        const int pnl = gate ? u.pn - 12 : u.pn;
        const int col0 = pnl * BM + wc * 32 + 8 * fq;
        const int bcol0 = u.pn * BM + wc * 32 + 8 * fq + (gate ? 4 : 0);
        bf16_t* dst = gate ? G : QKV;
        const bool isq = (u.pn == 0) || (u.pn == 3) || (u.pn == 4) || (u.pn == 9);
        const float sc = isq ? (u.pn == 0 ? 0.125f : 0.125f * 1.4426950408889634f) : 1.0f;
        float bv[2][8];
#pragma unroll
        for (int bj = 0; bj < 2; ++bj)
#pragma unroll
            for (int e = 0; e < 8; ++e) bv[bj][e] = rsl[2048 + bj * HALF + wc * 32 + 8 * fq + e];
        (void)bcol0;
#pragma unroll
        for (int ai = 0; ai < 2; ++ai)
#pragma unroll
            for (int m = 0; m < 4; ++m) {
                bf16_t* p = dst + (size_t)(row0 + ai * HALF + m * 16) * 3072 + col0;
                const float rs = rsl[ai * HALF + wr * 64 + m * 16 + fr];
#pragma unroll
                for (int bj = 0; bj < 2; ++bj) {
                    float v[8];
#pragma unroll
                    for (int n = 0; n < 2; ++n)
#pragma unroll
                        for (int e = 0; e < 4; ++e) { float t = rs * acc[ai][bj][m][n][e] + bv[bj][n * 4 + e]; v[n * 4 + e] = gate ? fast_sigmoid(t) : t * sc; }
                    u32x4 w; w.x = pk_bf16(v[0], v[1]); w.y = pk_bf16(v[2], v[3]); w.z = pk_bf16(v[4], v[5]); w.w = pk_bf16(v[6], v[7]);
                    *(u32x4*)(p + bj * HALF) = w;
                }
            }
    }
};
struct EpiBranch {
    static constexpr bool PERM = true, AFTER_DRAIN = false, RSTD = false, RESCALE = false;
    const bf16_t* G; float* T; bf16_t* merged; int mode;
    __device__ __forceinline__ void operator()(const f32x4 (&acc)[2][2][4][2], const Unit& u, int wr, int wc, int fr, int fq, const PG8_LAS float*) const {
        const int row0 = u.pm * BM + wr * 64 + fr, col0 = u.pn * BM + wc * 32 + 8 * fq;
#pragma unroll
        for (int ai = 0; ai < 2; ++ai)
#pragma unroll
            for (int m = 0; m < 4; ++m) {
                const size_t row = (size_t)(row0 + ai * HALF + m * 16);
#pragma unroll
                for (int bj = 0; bj < 2; ++bj) {
                    const u32x4 gw = *(const u32x4*)(G + row * 3072 + col0 + bj * HALF);
                    f32x4 v0, v1;
                    v0[0] = bf_lo(gw.x) * acc[ai][bj][m][0][0]; v0[1] = bf_hi(gw.x) * acc[ai][bj][m][0][1];
                    v0[2] = bf_lo(gw.y) * acc[ai][bj][m][0][2]; v0[3] = bf_hi(gw.y) * acc[ai][bj][m][0][3];
                    v1[0] = bf_lo(gw.z) * acc[ai][bj][m][1][0]; v1[1] = bf_hi(gw.z) * acc[ai][bj][m][1][1];
                    v1[2] = bf_lo(gw.w) * acc[ai][bj][m][1][2]; v1[3] = bf_hi(gw.w) * acc[ai][bj][m][1][3];
                    float* tp = T + row * 1024 + col0 + bj * HALF;
                    if (mode != 0) { v0 += *(const f32x4*)tp; v1 += *(const f32x4*)(tp + 4); }
                    if (mode != 2) { *(f32x4*)tp = v0; *(f32x4*)(tp + 4) = v1; }
                    else { u32x4 w; w.x = pk_bf16(v0[0], v0[1]); w.y = pk_bf16(v0[2], v0[3]); w.z = pk_bf16(v1[0], v1[1]); w.w = pk_bf16(v1[2], v1[3]);
                           *(u32x4*)(merged + row * 1024 + col0 + bj * HALF) = w; }
                }
                asm volatile("" ::: "memory");
            }
    }
};

struct EpiBranch1 {
    static constexpr bool PERM = true, AFTER_DRAIN = false, RSTD = false, RESCALE = true;
    const bf16_t* G; bf16_t* merged;
    static __device__ __forceinline__ float fl(float g) { return fmaxf(g, 1e-30f); }
    __device__ __forceinline__ void rescale(f32x4 (&acc)[2][2][4][2], const Unit& u, int wr, int wc, int fr, int fq, int from) const {
        const int row0 = u.pm * BM + wr * 64 + fr, col0 = u.pn * BM + wc * 32 + 8 * fq + from * 1024;
#pragma unroll
        for (int ai = 0; ai < 2; ++ai)
#pragma unroll
            for (int m = 0; m < 4; ++m) {
                const bf16_t* gp = G + (size_t)(row0 + ai * HALF + m * 16) * 3072 + col0;
#pragma unroll
                for (int bj = 0; bj < 2; ++bj) {
                    const u32x4 a = *(const u32x4*)(gp + bj * HALF), b = *(const u32x4*)(gp + bj * HALF + 1024);
                    acc[ai][bj][m][0][0] *= fl(bf_lo(a.x)) * __builtin_amdgcn_rcpf(fl(bf_lo(b.x))); acc[ai][bj][m][0][1] *= fl(bf_hi(a.x)) * __builtin_amdgcn_rcpf(fl(bf_hi(b.x)));
                    acc[ai][bj][m][0][2] *= fl(bf_lo(a.y)) * __builtin_amdgcn_rcpf(fl(bf_lo(b.y))); acc[ai][bj][m][0][3] *= fl(bf_hi(a.y)) * __builtin_amdgcn_rcpf(fl(bf_hi(b.y)));
                    acc[ai][bj][m][1][0] *= fl(bf_lo(a.z)) * __builtin_amdgcn_rcpf(fl(bf_lo(b.z))); acc[ai][bj][m][1][1] *= fl(bf_hi(a.z)) * __builtin_amdgcn_rcpf(fl(bf_hi(b.z)));
                    acc[ai][bj][m][1][2] *= fl(bf_lo(a.w)) * __builtin_amdgcn_rcpf(fl(bf_lo(b.w))); acc[ai][bj][m][1][3] *= fl(bf_hi(a.w)) * __builtin_amdgcn_rcpf(fl(bf_hi(b.w)));
                }
            }
    }
    __device__ __forceinline__ void operator()(const f32x4 (&acc)[2][2][4][2], const Unit& u, int wr, int wc, int fr, int fq, const PG8_LAS float*) const {
        const int row0 = u.pm * BM + wr * 64 + fr, col0 = u.pn * BM + wc * 32 + 8 * fq;
#pragma unroll
        for (int ai = 0; ai < 2; ++ai)
#pragma unroll
            for (int m = 0; m < 4; ++m) {
                const size_t row = (size_t)(row0 + ai * HALF + m * 16);
#pragma unroll
                for (int bj = 0; bj < 2; ++bj) {
                    const u32x4 g = *(const u32x4*)(G + row * 3072 + 2048 + col0 + bj * HALF);
                    u32x4 w;
                    w.x = pk_bf16(acc[ai][bj][m][0][0] * fl(bf_lo(g.x)), acc[ai][bj][m][0][1] * fl(bf_hi(g.x)));
                    w.y = pk_bf16(acc[ai][bj][m][0][2] * fl(bf_lo(g.y)), acc[ai][bj][m][0][3] * fl(bf_hi(g.y)));
                    w.z = pk_bf16(acc[ai][bj][m][1][0] * fl(bf_lo(g.z)), acc[ai][bj][m][1][1] * fl(bf_hi(g.z)));
                    w.w = pk_bf16(acc[ai][bj][m][1][2] * fl(bf_lo(g.w)), acc[ai][bj][m][1][3] * fl(bf_hi(g.w)));
                    *(u32x4*)(merged + row * 1024 + col0 + bj * HALF) = w;
                }
                if (m & 1) asm volatile("" ::: "memory");
            }
    }
};

template <class Epi, class Sched, int K_, int LDA_, int LDB_>
__device__ __forceinline__ void gemm_phase(PG8_LAS unsigned char* lds, const Gemm g, const Sched S, const Epi E) {
    int tid_ = threadIdx.x; asm volatile("" : "+v"(tid_));
    const int tid = tid_, wid = __builtin_amdgcn_readfirstlane(tid >> 6), lane = tid & 63, wr = wid >> 2, wc = wid & 3, fr = lane & 15, fq = lane >> 4;
    constexpr int nt = K_ / BK;
    unsigned voffA[2], voffB[2];
#pragma unroll
    for (int i = 0; i < 2; ++i) { int R, C; stage_rc(tid * 16 + i * 8192, R, C); const int Rb = Epi::PERM ? ((R & ~31) + perm32(R & 31)) : R;
        voffA[i] = (unsigned)(R * LDA_ + C) * 2u; voffB[i] = (unsigned)(Rb * LDB_ + C) * 2u; }
    constexpr size_t kstep = (size_t)(BK * 2);
    constexpr size_t hstepA = (size_t)HALF * LDA_ * 2, hstepB = (size_t)HALF * LDB_ * 2;
    constexpr size_t tstepA = 2 * hstepA, tstepB = 2 * hstepB;
    const unsigned ldsw = (unsigned)wid * 1024u;
    const int aoff = lds_byte(wr * 64 + fr, fq * 8), boff = lds_byte(wc * 32 + fr, fq * 8);
#define PG8_SA(b, h) (((b) * 2 + (h)) * HTB)
#define PG8_SB(b, h) ((4 + (b) * 2 + (h)) * HTB)
#define PG8_STAGE(bufoff, gbase, voff) do { _Pragma("unroll") for (int _i = 0; _i < 2; ++_i) \
        __builtin_amdgcn_global_load_lds((const unsigned*)((const char*)(gbase) + (voff)[_i]), (PG8_LAS unsigned*)(lds + (bufoff) + ldsw + _i * 8192), 16, 0, 0); } while (0)
#define PG8_LDA(dst, b, h) do { _Pragma("unroll") for (int m = 0; m < 4; ++m) _Pragma("unroll") for (int k = 0; k < 2; ++k) dst[m][k] = *(const PG8_LAS bf16x8*)(lds + PG8_SA(b, h) + aoff + m * 2048 + k * 1024); } while (0)
#define PG8_LDB(dst, b, h) do { _Pragma("unroll") for (int n = 0; n < 2; ++n) _Pragma("unroll") for (int k = 0; k < 2; ++k) dst[n][k] = *(const PG8_LAS bf16x8*)(lds + PG8_SB(b, h) + boff + n * 2048 + k * 1024); } while (0)
#define PG8_MMA(ai, bj, At, Bt) do { __builtin_amdgcn_s_setprio(1); _Pragma("unroll") for (int m = 0; m < 4; ++m) _Pragma("unroll") for (int n = 0; n < 2; ++n) _Pragma("unroll") for (int k = 0; k < 2; ++k) \
        acc[ai][bj][m][n] = __builtin_amdgcn_mfma_f32_16x16x32_bf16(Bt[n][k], At[m][k], acc[ai][bj][m][n], 0, 0, 0); __builtin_amdgcn_s_setprio(0); } while (0)
#define PG8_WAIT_V(n) asm volatile("s_waitcnt vmcnt(" #n ")" ::: "memory")
#define PG8_WAIT_L(n) asm volatile("s_waitcnt lgkmcnt(" #n ")" ::: "memory")
#define PG8_BAR __builtin_amdgcn_s_barrier()
#define PG8_SCHED __builtin_amdgcn_sched_barrier(0)
    Unit cur, nxt; int ui = 0;
    if (!S.next(0, cur)) return;
    PG8_LAS float* rsl = (PG8_LAS float*)(lds + STAGE_BYTES);
    f32x4 acc[2][2][4][2];
#pragma unroll
    for (int a = 0; a < 2; ++a)
#pragma unroll
        for (int b = 0; b < 2; ++b)
#pragma unroll
            for (int m = 0; m < 4; ++m)
#pragma unroll
                for (int n = 0; n < 2; ++n) acc[a][b][m][n] = (f32x4){0.f, 0.f, 0.f, 0.f};
    bf16x8 At[4][2], B0[2][2], B1[2][2];
    const char* cA = (const char*)g.A + (size_t)cur.pm * tstepA; const char* cB = (const char*)g.Bt + (size_t)cur.pn * tstepB;
    PG8_STAGE(PG8_SB(0, 0), cB, voffB); PG8_STAGE(PG8_SB(0, 1), cB + hstepB, voffB); PG8_STAGE(PG8_SA(0, 0), cA, voffA); PG8_STAGE(PG8_SA(0, 1), cA + hstepA, voffA);
    if constexpr (Epi::RSTD) {
        Unit uu;
        for (int i = 0; i < 8 && S.next(i, uu); ++i) if (tid < 256) {
            rsl[i * 256 + tid] = row_rstd(E.part, uu.pm * BM + tid);
            if constexpr (Epi::BIAS) { if (i < 6) rsl[2048 + i * 256 + tid] = E.bias[uu.pn * BM + tid + (uu.pn >= 12 ? 4 : 0)]; }
        }
        asm volatile("s_waitcnt lgkmcnt(0)" ::: "memory"); __builtin_amdgcn_s_barrier(); asm volatile("" ::: "memory");
    }
    if (wr == 1) PG8_BAR;
    PG8_WAIT_V(2); PG8_BAR;
    PG8_STAGE(PG8_SB(1, 0), cB + kstep, voffB); PG8_STAGE(PG8_SA(1, 0), cA + kstep, voffA); PG8_STAGE(PG8_SB(1, 1), cB + hstepB + kstep, voffB);
    PG8_WAIT_V(6); PG8_BAR;
    for (;;) {
        const bool has_next = S.next(ui + 1, nxt);
        const char* nA = has_next ? (const char*)g.A + (size_t)nxt.pm * tstepA : cA; const char* nB = has_next ? (const char*)g.Bt + (size_t)nxt.pn * tstepB : cB;
        for (int t = 0; t < nt; t += 2) {
            if constexpr (Epi::RESCALE) {
                if (t == 4 || t == 12) { int t3 = threadIdx.x; asm volatile("" : "+v"(t3)); const int l3 = t3 & 63; E.rescale(acc, cur, wr, wc, l3 & 15, l3 >> 4, t == 4 ? 0 : 1); }
            }
            const bool last = (t == nt - 2);
            const char* a1 = cA + (size_t)(t + 1) * kstep;
            const char* a2 = last ? nA : cA + (size_t)(t + 2) * kstep; const char* b2 = last ? nB : cB + (size_t)(t + 2) * kstep;
            const char* a3 = a2 + kstep; const char* b3 = b2 + kstep;
            PG8_LDB(B0, 0, 0); PG8_LDB(B1, 0, 1); PG8_SCHED; PG8_LDA(At, 0, 0); PG8_STAGE(PG8_SA(1, 1), a1 + hstepA, voffA);
            PG8_WAIT_V(8); PG8_WAIT_L(0); PG8_BAR; PG8_MMA(0, 0, At, B0); PG8_MMA(0, 1, At, B1); PG8_BAR; PG8_SCHED;
            PG8_LDA(At, 0, 1); PG8_STAGE(PG8_SB(0, 0), b2, voffB); PG8_STAGE(PG8_SB(0, 1), b2 + hstepB, voffB); PG8_STAGE(PG8_SA(0, 0), a2, voffA);
            PG8_WAIT_V(8); PG8_WAIT_L(0); PG8_BAR; PG8_MMA(1, 0, At, B0); PG8_MMA(1, 1, At, B1); PG8_BAR; PG8_SCHED;
            PG8_LDB(B0, 1, 0); PG8_LDB(B1, 1, 1); PG8_SCHED; PG8_LDA(At, 1, 0); PG8_STAGE(PG8_SA(0, 1), a2 + hstepA, voffA);
            PG8_WAIT_V(8); PG8_WAIT_L(0); PG8_BAR; PG8_MMA(0, 0, At, B0); PG8_MMA(0, 1, At, B1); PG8_BAR; PG8_SCHED;
            PG8_LDA(At, 1, 1); PG8_STAGE(PG8_SB(1, 0), b3, voffB); PG8_STAGE(PG8_SB(1, 1), b3 + hstepB, voffB); PG8_STAGE(PG8_SA(1, 0), a3, voffA);
            PG8_WAIT_V(8); PG8_WAIT_L(0); PG8_BAR; PG8_MMA(1, 0, At, B0); PG8_MMA(1, 1, At, B1); PG8_BAR; PG8_SCHED;
        }
        if (wr == 0) PG8_BAR;
        { int t2 = threadIdx.x; asm volatile("" : "+v"(t2));
          const int l2 = t2 & 63; if constexpr (!Epi::AFTER_DRAIN) E(acc, cur, wr, wc, l2 & 15, l2 >> 4, rsl + ui * 256); }
        if (!has_next) break;
#pragma unroll
        for (int a = 0; a < 2; ++a)
#pragma unroll
            for (int b = 0; b < 2; ++b)
#pragma unroll
                for (int m = 0; m < 4; ++m)
#pragma unroll
                    for (int n = 0; n < 2; ++n) acc[a][b][m][n] = (f32x4){0.f, 0.f, 0.f, 0.f};
        cur = nxt; cA = nA; cB = nB; ++ui;
        if (wr == 1) PG8_BAR;
    }
    PG8_WAIT_V(0);
    PG8_BAR;
    if constexpr (Epi::AFTER_DRAIN) { int t2 = threadIdx.x; asm volatile("" : "+v"(t2)); const int l2 = t2 & 63; E.fused(acc, cur, wr, wc, l2 & 15, l2 >> 4, lds, t2); PG8_BAR; }
#undef PG8_SA
#undef PG8_SB
#undef PG8_STAGE
#undef PG8_LDA
#undef PG8_LDB
#undef PG8_MMA
#undef PG8_WAIT_V
#undef PG8_WAIT_L
#undef PG8_BAR
#undef PG8_SCHED
}
}

typedef unsigned short bf16;
typedef float f32x4 __attribute__((ext_vector_type(4)));
typedef unsigned v4u __attribute__((ext_vector_type(4)));
typedef unsigned v2u __attribute__((ext_vector_type(2)));
#define LAS __attribute__((address_space(3)))
constexpr int DM = 1024, NB = 8, SEQ = 2048, M = NB * SEQ, DFF = 2816, INW = 6148, QW = 3072, NREL = 257;
constexpr int NWAVES = 8;
constexpr float RMS_EPS = 1e-6f;
constexpr float LOG2E = 1.4426950408889634f, LN2 = 0.6931471805599453f;

constexpr size_t MiB = 1u << 20;
constexpr size_t WS_CTL = 0;
constexpr int CW_BAR = 1024;
constexpr int CW_PANEL = 8192;
constexpr size_t WS_PART = 64 * 1024;
constexpr size_t WS_FC = WS_PART + 256 * 1024;
constexpr size_t WS_WMIX = 1 * MiB;
constexpr size_t WMIX_LAYER = 16 * MiB, WMIX_BR = 12 * MiB, WMIX_OUT = 14 * MiB;
constexpr size_t WS_XN = 33 * MiB;
constexpr size_t WS_R1 = 65 * MiB;
constexpr size_t WS_MERGED = WS_R1, WS_T = WS_R1 + 32 * MiB;
constexpr size_t FFN_SLOT = 17 * MiB, FFN_SLOT_OUT = 11 * MiB;
constexpr size_t WS_R2 = 161 * MiB;
constexpr size_t WS_PARTD = 257 * MiB;
constexpr size_t WS_END = 258 * MiB;
static_assert(WS_END <= 272000000ull, "workspace budget");
static_assert(3 * FFN_SLOT <= 64 * MiB, "ffn slots inside T");

constexpr int LDS_BYTES = 147456;

__device__ __forceinline__ unsigned f2bf(float f) { unsigned u = __builtin_bit_cast(unsigned, f); return (u + 0x7fffu + ((u >> 16) & 1u)) >> 16; }
__device__ __forceinline__ unsigned pk2(float lo, float hi) { return f2bf(lo) | (f2bf(hi) << 16); }
__device__ __forceinline__ float bf2f(bf16 v) { return __uint_as_float(((unsigned)v) << 16); }
__device__ __forceinline__ float wave_sum(float v, int lane) {
#pragma unroll
    for (int o = 1; o < 64; o <<= 1) v += __int_as_float(__builtin_amdgcn_ds_bpermute((lane ^ o) << 2, __float_as_int(v)));
    return v;
}

__device__ __forceinline__ void tr_item(const float* W, int N, int k0, int n0, bf16* WT, int ldt, int drow0, int dk0, LAS float* scr, int lane, const float* gk) {
    const int c4 = 4 * (lane & 7), r8 = lane >> 3;
    f32x4 v[8];
#pragma unroll
    for (int i = 0; i < 8; ++i) v[i] = __builtin_nontemporal_load((const f32x4*)(W + (size_t)(k0 + 8 * i + r8) * N + n0 + c4));
#pragma unroll
    for (int i = 0; i < 8; ++i) { LAS float* d = scr + (8 * i + r8) * 33 + c4; d[0] = v[i][0]; d[1] = v[i][1]; d[2] = v[i][2]; d[3] = v[i][3]; }
    asm volatile("s_waitcnt lgkmcnt(0)" ::: "memory");
    const int c = lane & 7;
    f32x4 ga = {1.f, 1.f, 1.f, 1.f}, gb = {1.f, 1.f, 1.f, 1.f};
    if (gk) { ga = *(const f32x4*)(gk + k0 + 8 * c); gb = *(const f32x4*)(gk + k0 + 8 * c + 4); }
#pragma unroll
    for (int j = 0; j < 4; ++j) { const int n = (lane >> 3) + 8 * j; const LAS float* s = scr + (8 * c) * 33 + n;
        v4u o; o.x = pk2(s[0 * 33] * ga[0], s[1 * 33] * ga[1]); o.y = pk2(s[2 * 33] * ga[2], s[3 * 33] * ga[3]); o.z = pk2(s[4 * 33] * gb[0], s[5 * 33] * gb[1]); o.w = pk2(s[6 * 33] * gb[2], s[7 * 33] * gb[3]);
        *(v4u*)(WT + (size_t)(drow0 + n) * ldt + dk0 + k0 + 8 * c) = o; }
    asm volatile("s_waitcnt lgkmcnt(0)" ::: "memory");
}
__device__ __forceinline__ void conv_matrix(const float* W, int K, int N, int nblk, int kind, bf16* WT, int ldt, int dk0, LAS float* scr, int gw, int NGW, int lane, const float* gk = nullptr, int off = 0) {
    const int nitems = (K / 64) * nblk;
    for (int it = (gw + NGW - off % NGW) % NGW; it < nitems; it += NGW) {
        const int kb = it / nblk, nb = it % nblk;
        int n0 = 32 * nb, drow0 = n0;
        if (kind == 1) { const int up = n0 >= DFF, j0 = n0 - up * DFF; drow0 = (j0 >> 7) * 256 + (j0 & 127) + up * 128; }
        else if (kind == 2) { if (nb >= 96) n0 += 4; }
        tr_item(W, N, 64 * kb, n0, WT, ldt, drow0, dk0, scr, lane, gk);
    }
}

struct Args { const float* in[16]; float* out; unsigned char* ws; int ph_lo, ph_hi; };
constexpr int PTAB_OFF = 147456 - 256;
#define GAS_ __attribute__((address_space(1)))
#define PTR_(i) ((const float*)(GAS_ const float*)ld_ptr(lds, (i)))
__device__ __forceinline__ unsigned long long ld_ptr(LAS unsigned char* lds, int i) {
    const unsigned long long v = *((volatile LAS unsigned long long*)(lds + PTAB_OFF) + i);
    const unsigned lo = __builtin_amdgcn_readfirstlane((unsigned)v), hi = __builtin_amdgcn_readfirstlane((unsigned)(v >> 32));
    return ((unsigned long long)hi << 32) | lo;
}

__device__ __forceinline__ void conv_ffn(LAS unsigned char* lds, unsigned char* ws, int layer, int which  , int slot, LAS float* scr, int gw, int NGW, int lane, int parts = 3  , int off = 0) {
    const float* win = PTR_(which ? 13 : 2) + (size_t)layer * DM * 2 * DFF;
    const float* wout = PTR_(which ? 14 : 3) + (size_t)layer * DFF * DM;
    bf16* s = (bf16*)(ws + WS_T + (size_t)slot * FFN_SLOT);
    if (parts & 1) { conv_matrix(win, DM, 2 * DFF, 2 * DFF / 32, 1, s, DM, 0, scr, gw, NGW, lane, PTR_(which ? 12 : 1) + layer * DM, off); off += 2816; }
    if (parts & 2) conv_matrix(wout, DFF, DM, DM / 32, 0, (bf16*)((unsigned char*)s + FFN_SLOT_OUT), DFF, 0, scr, gw, NGW, lane, nullptr, off);
}
__device__ __forceinline__ void conv_mix(LAS unsigned char* lds, unsigned char* ws, int layer, LAS float* scr, int gw, int NGW, int lane, int off = 0) {
    unsigned char* wb = ws + WS_WMIX + (size_t)layer * WMIX_LAYER;
    conv_matrix(PTR_(5) + (size_t)layer * DM * INW, DM, INW, 192, 2, (bf16*)wb, DM, 0, scr, gw, NGW, lane, PTR_(4) + layer * DM, off);
    conv_matrix(PTR_(8) + (size_t)layer * 256 * DM, 256, DM, 32, 0, (bf16*)(wb + WMIX_BR), DM, 0, scr, gw, NGW, lane, nullptr, off + 3072);
    conv_matrix(PTR_(9) + (size_t)layer * 512 * DM, 512, DM, 32, 0, (bf16*)(wb + WMIX_BR), DM, 256, scr, gw, NGW, lane, nullptr, off + 3200);
    conv_matrix(PTR_(10) + (size_t)layer * 256 * DM, 256, DM, 32, 0, (bf16*)(wb + WMIX_BR), DM, 768, scr, gw, NGW, lane, nullptr, off + 3456);
    conv_matrix(PTR_(11) + (size_t)layer * DM * DM, DM, DM, 32, 0, (bf16*)(wb + WMIX_OUT), DM, 0, scr, gw, NGW, lane, nullptr, off + 3584);
}

template <int MODE>
__device__ __forceinline__ void norm_rows(const float* x, const float* g, bf16* xn, float* fout, const float* wf  , const float* bf_, float* fl, int gw, int NGW, int lane) {
    f32x4 gv[4];
#pragma unroll
    for (int j = 0; j < 4; ++j) gv[j] = *((const f32x4*)g + 64 * j + lane);
    f32x4 wv[4][4];
    if (MODE == 1) {
#pragma unroll
        for (int j = 0; j < 4; ++j)
#pragma unroll
            for (int e = 0; e < 4; ++e) { const int k = 256 * j + 4 * lane + e; const f32x4 w4 = *(const f32x4*)(wf + (size_t)k * INW + QW);
                wv[0][j][e] = w4[0]; wv[1][j][e] = w4[1]; wv[2][j][e] = w4[2]; wv[3][j][e] = w4[3]; }
    }
    for (int m = gw; m < M; m += NGW) {
        const f32x4* xr = (const f32x4*)(x + (size_t)m * DM) + lane;
        f32x4 v[4]; float s = 0.f;
#pragma unroll
        for (int j = 0; j < 4; ++j) { v[j] = xr[64 * j]; s += (v[j][0] * v[j][0] + v[j][1] * v[j][1]) + (v[j][2] * v[j][2] + v[j][3] * v[j][3]); }
        const float rstd = 1.0f / sqrtf(wave_sum(s, lane) * (1.0f / DM) + RMS_EPS);
#pragma unroll
        for (int j = 0; j < 4; ++j) v[j] = v[j] * rstd * gv[j];
        if (MODE == 2) {
            f32x4* o = (f32x4*)(fout + (size_t)m * DM) + lane;
#pragma unroll
            for (int j = 0; j < 4; ++j) o[64 * j] = v[j];
        } else {
            v2u* o8 = (v2u*)(xn + (size_t)m * DM) + lane;
#pragma unroll
            for (int j = 0; j < 4; ++j) { v2u w; w.x = pk2(v[j][0], v[j][1]); w.y = pk2(v[j][2], v[j][3]); o8[64 * j] = w; }
        }
        if (MODE == 1) {
            float d[4];
#pragma unroll
            for (int h = 0; h < 4; ++h) { float t = 0.f;
#pragma unroll
                for (int j = 0; j < 4; ++j) t += (v[j][0] * wv[h][j][0] + v[j][1] * wv[h][j][1]) + (v[j][2] * wv[h][j][2] + v[j][3] * wv[h][j][3]);
                d[h] = wave_sum(t, lane); }
            if (lane < 4) { const float z = (lane == 0 ? d[0] : lane == 1 ? d[1] : lane == 2 ? d[2] : d[3]) + bf_[lane];
                const float lf = fminf(z, 0.f) - log1pf(expf(-fabsf(z)));
                const int b = m / SEQ, t = m % SEQ; fl[(size_t)(b * 4 + lane) * SEQ + t] = lf; }
        }
    }
}

__device__ __forceinline__ void rows_raw(const float* x, bf16* xb, float* part, int gw, int NGW, int lane) {
    for (int m = gw; m < M; m += NGW) {
        const f32x4* xr = (const f32x4*)(x + (size_t)m * DM) + lane;
        f32x4 v[4]; float s = 0.f;
#pragma unroll
        for (int j = 0; j < 4; ++j) { v[j] = __builtin_nontemporal_load(xr + 64 * j); s += (v[j][0] * v[j][0] + v[j][1] * v[j][1]) + (v[j][2] * v[j][2] + v[j][3] * v[j][3]); }
        s = wave_sum(s, lane);
        v2u* o8 = (v2u*)(xb + (size_t)m * DM) + lane;
#pragma unroll
        for (int j = 0; j < 4; ++j) { v2u w; w.x = pk2(v[j][0], v[j][1]); w.y = pk2(v[j][2], v[j][3]); o8[64 * j] = w; }
        if (lane < 4) part[(size_t)lane * M + m] = lane == 0 ? s : 0.f;
    }
}

__device__ __forceinline__ void cumsum_seq(const float* part, const float* partd, const float* bfg  , float* fc, int seq, LAS float* scr, int tid) {
    const int lane = tid & 63, wid = tid >> 6, b = seq >> 2, hh = seq & 3;
    const float bias = bfg[hh];
    float lf[4];
#pragma unroll
    for (int e = 0; e < 4; ++e) {
        const int m = b * SEQ + 4 * tid + e;
        const float rs = pg8::row_rstd(part, m);
        const float dot = (partd[((size_t)m) * 4 + hh] + partd[((size_t)M + m) * 4 + hh]) + (partd[((size_t)2 * M + m) * 4 + hh] + partd[((size_t)3 * M + m) * 4 + hh]);
        const float z = rs * dot + bias;
        lf[e] = fminf(z, 0.f) - log1pf(expf(-fabsf(z)));
    }
    const float s1 = lf[0], s2 = s1 + lf[1], s3 = s2 + lf[2], s4 = s3 + lf[3];
    float inc = s4;
#pragma unroll
    for (int o = 1; o < 64; o <<= 1) { const float t = __int_as_float(__builtin_amdgcn_ds_bpermute(((lane - o) & 63) << 2, __float_as_int(inc))); if (lane >= o) inc += t; }
    if (lane == 63) scr[wid] = inc;
    __syncthreads();
    float base = 0.f;
    for (int w = 0; w < wid; ++w) base += scr[w];
    const float ex = base + inc - s4;
    f32x4 o; o[0] = ex + s1; o[1] = ex + s2; o[2] = ex + s3; o[3] = ex + s4;
    *((f32x4*)(fc + (size_t)seq * SEQ) + tid) = o * (-LOG2E);
    __syncthreads();
}

#define DOT64(z, q, kp) do { z = 0.f; _Pragma("unroll") for (int c_ = 0; c_ < 8; ++c_) { const v4u w_ = *((const v4u*)(kp) + c_); const v4u q_ = q[c_]; \
    z += pg8::bf_lo(q_[0]) * pg8::bf_lo(w_[0]) + pg8::bf_hi(q_[0]) * pg8::bf_hi(w_[0]) + pg8::bf_lo(q_[1]) * pg8::bf_lo(w_[1]) + pg8::bf_hi(q_[1]) * pg8::bf_hi(w_[1]) \
       + pg8::bf_lo(q_[2]) * pg8::bf_lo(w_[2]) + pg8::bf_hi(q_[2]) * pg8::bf_hi(w_[2]) + pg8::bf_lo(q_[3]) * pg8::bf_lo(w_[3]) + pg8::bf_hi(q_[3]) * pg8::bf_hi(w_[3]); } } while (0)
#define AXPY64(o, wt_, vp) do { _Pragma("unroll") for (int c_ = 0; c_ < 8; ++c_) { const v4u w_ = *((const v4u*)(vp) + c_); \
    o[c_ * 8 + 0] += (wt_) * pg8::bf_lo(w_[0]); o[c_ * 8 + 1] += (wt_) * pg8::bf_hi(w_[0]); o[c_ * 8 + 2] += (wt_) * pg8::bf_lo(w_[1]); o[c_ * 8 + 3] += (wt_) * pg8::bf_hi(w_[1]); \
    o[c_ * 8 + 4] += (wt_) * pg8::bf_lo(w_[2]); o[c_ * 8 + 5] += (wt_) * pg8::bf_hi(w_[2]); o[c_ * 8 + 6] += (wt_) * pg8::bf_lo(w_[3]); o[c_ * 8 + 7] += (wt_) * pg8::bf_hi(w_[3]); } } while (0)
#define LOADQ(q, qp) do { _Pragma("unroll") for (int c_ = 0; c_ < 8; ++c_) q[c_] = *((const v4u*)(qp) + c_); } while (0)
#define STOREO(op, o, sc) do { _Pragma("unroll") for (int c_ = 0; c_ < 8; ++c_) { v4u w_; w_.x = pk2(o[c_ * 8 + 0] * (sc), o[c_ * 8 + 1] * (sc)); w_.y = pk2(o[c_ * 8 + 2] * (sc), o[c_ * 8 + 3] * (sc)); \
    w_.z = pk2(o[c_ * 8 + 4] * (sc), o[c_ * 8 + 5] * (sc)); w_.w = pk2(o[c_ * 8 + 6] * (sc), o[c_ * 8 + 7] * (sc)); *((v4u*)(op) + c_) = w_; } } while (0)

__device__ __forceinline__ void attn_naive(const bf16* QKV, bf16* O, const float* fc, const float* rel  , int gw, int NGW, int lane, unsigned mask) {
    for (int wu = gw; wu < 4096; wu += NGW) {
        { const int mx_ = wu < 1024 ? 0 : (wu < 2048 ? 2 : 1); if (!((mask >> mx_) & 1u)) continue; }
        v4u q[8]; float o[64];
#pragma unroll
        for (int d = 0; d < 64; ++d) o[d] = 0.f;
        if (wu < 1024) {
            const int blk = 31 - (wu >> 5), bh = wu & 31, b = bh >> 2, h = bh & 3;
            const int t = blk * 64 + lane; const size_t row = (size_t)b * SEQ + t;
            const bf16* kb = QKV + (size_t)b * SEQ * QW + 256 + h * 64; const bf16* vb = kb + 256;
            LOADQ(q, QKV + row * QW + h * 64);
            float R = 0.f;
            for (int s = blk * 64 + 62; s >= 0; --s) {
                float z; DOT64(z, q, kb + (size_t)s * QW);
                const bool act = s < t;
                const float sp = fmaxf(z, 0.f) + log1pf(expf(-fabsf(z)));
                const float w = act ? expf(z - sp + R) : 0.f;
                R -= act ? sp : 0.f;
                AXPY64(o, w, vb + (size_t)s * QW);
            }
            STOREO(O + row * DM + h * 64, o, 1.0f);
        } else if (wu < 2048) {
            const int u = wu - 1024; const int blk = 31 - (u >> 5), bh = u & 31, b = bh >> 2, h = bh & 3;
            const int t = blk * 64 + lane; const size_t row = (size_t)b * SEQ + t;
            const bf16* kb = QKV + (size_t)b * SEQ * QW + 2560 + h * 64; const bf16* vb = kb + 256;
            const float* F = fc + (size_t)bh * SEQ;
            LOADQ(q, QKV + row * QW + 2304 + h * 64);
            float mx = -1e30f, l = 0.f;
            for (int s = 0; s <= blk * 64 + 63; ++s) {
                float z; DOT64(z, q, kb + (size_t)s * QW);
                z -= F[s];
                const bool act = s <= t;
                const float mn = act ? fmaxf(mx, z) : mx;
                const float al = expf(mx - mn), p = act ? expf(z - mn) : 0.f;
                mx = mn; l = l * al + p;
#pragma unroll
                for (int d = 0; d < 64; ++d) o[d] *= al;
                AXPY64(o, p, vb + (size_t)s * QW);
            }
            const float il = 1.0f / l;
            STOREO(O + row * DM + 768 + h * 64, o, il);
        } else {
            const int u = wu - 2048; const int c = u >> 6, bh = u & 63, b = bh >> 3, h = bh & 7;
            const int t = c * 64 + lane; const size_t row = (size_t)b * SEQ + t;
            const bf16* kb = QKV + (size_t)b * SEQ * QW + 1280 + h * 64; const bf16* vb = kb + 512;
            LOADQ(q, QKV + row * QW + 768 + h * 64);
            float mx = -1e30f, l = 0.f;
            const int s_lo = c >= 8 ? (c - 8) * 64 : 0;
            for (int s = s_lo; s <= c * 64 + 63; ++s) {
                float z; DOT64(z, q, kb + (size_t)s * QW);
                int rl = t - s; rl = rl > 128 ? 128 : (rl < -128 ? -128 : rl);
                z += rel[(rl + 128) * 8 + h];
                const float mn = fmaxf(mx, z);
                const float al = expf(mx - mn), p = expf(z - mn);
                mx = mn; l = l * al + p;
#pragma unroll
                for (int d = 0; d < 64; ++d) o[d] *= al;
                AXPY64(o, p, vb + (size_t)s * QW);
            }
            const float il = 1.0f / l;
            STOREO(O + row * DM + 256 + h * 64, o, il);
        }
    }
}

namespace att {
typedef short bf16x8 __attribute__((ext_vector_type(8)));
typedef short s16x4 __attribute__((ext_vector_type(4)));
typedef float f32x16 __attribute__((ext_vector_type(16)));
constexpr int WLDS = 17664;
__device__ __forceinline__ int crow(int r, int h) { return (r & 3) + 8 * (r >> 2) + 4 * h; }
__device__ __forceinline__ float xchg32(float v, int lane) { return __int_as_float(__builtin_amdgcn_ds_bpermute((lane ^ 32) << 2, __float_as_int(v))); }
__device__ __forceinline__ float ex2(float v) { return __builtin_amdgcn_exp2f(v); }
__device__ __forceinline__ float lg2(float v) { return __builtin_amdgcn_logf(v); }

__device__ __forceinline__ void load_k(bf16x8 (&k)[2][4], const bf16* kb) {
#pragma unroll
    for (int hf = 0; hf < 2; ++hf)
#pragma unroll
        for (int d0 = 0; d0 < 4; ++d0) k[hf][d0] = *(const bf16x8*)(kb + (size_t)(32 * hf) * QW + 16 * d0);
}
__device__ __forceinline__ void glds16(const void* gsrc, unsigned lds_dst) {
    unsigned keep;
    asm volatile("s_mov_b32 %0, m0\n\ts_mov_b32 m0, %2\n\ts_nop 0\n\tglobal_load_lds_dwordx4 %1, off\n\ts_mov_b32 m0, %0" : "=&s"(keep) : "v"(gsrc), "s"(lds_dst) : "memory");
}
__device__ __forceinline__ void dma_v(LAS unsigned char* vimg, const bf16* vb) {
    const unsigned dst = (unsigned)__builtin_amdgcn_readfirstlane((int)(unsigned)(uintptr_t)vimg);
#pragma unroll
    for (int i = 0; i < 8; ++i) glds16(vb + (size_t)(16 * (i >> 1)) * QW + 32 * (i & 1), dst + (unsigned)((i & 1) * 4096 + (i >> 1) * 1024));
}
__device__ __forceinline__ void wait_v() { asm volatile("s_waitcnt vmcnt(0)" ::: "memory"); }
__device__ __forceinline__ void qk(f32x16 (&S)[2], const bf16x8 (&k)[2][4], const bf16x8 (&q)[4]) {
    __builtin_amdgcn_s_setprio(1);
#pragma unroll
    for (int hf = 0; hf < 2; ++hf) {
        f32x16 acc = S[hf];
#pragma unroll
        for (int d0 = 0; d0 < 4; ++d0) acc = __builtin_amdgcn_mfma_f32_32x32x16_bf16(k[hf][d0], q[d0], acc, 0, 0, 0);
        S[hf] = acc;
    }
    __builtin_amdgcn_s_setprio(0);
}
__device__ __forceinline__ s16x4 vtr(LAS unsigned char* p) {
    typedef short v4i16_t __attribute__((ext_vector_type(4)));
    return __builtin_bit_cast(s16x4, __builtin_amdgcn_ds_read_tr16_b64_v4i16((LAS v4i16_t*)p));
}
__device__ __forceinline__ void pv(f32x16 (&o)[2], LAS unsigned char* vimg, int lane, const f32x16 (&S)[2]) {
    const int h = lane >> 5;
    LAS unsigned char* vb = vimg + (4 * h + ((lane & 15) >> 2)) * 64 + ((lane >> 4) & 1) * 32 + (lane & 3) * 8;
#pragma unroll
    for (int hf = 0; hf < 2; ++hf)
#pragma unroll
        for (int s = 0; s < 2; ++s) {
            v4u pw; pw[0] = pg8::pk_bf16(S[hf][8 * s + 0], S[hf][8 * s + 1]); pw[1] = pg8::pk_bf16(S[hf][8 * s + 2], S[hf][8 * s + 3]);
            pw[2] = pg8::pk_bf16(S[hf][8 * s + 4], S[hf][8 * s + 5]); pw[3] = pg8::pk_bf16(S[hf][8 * s + 6], S[hf][8 * s + 7]);
            const bf16x8 pf = __builtin_bit_cast(bf16x8, pw);
#pragma unroll
            for (int db = 0; db < 2; ++db) {
                LAS unsigned char* p = vb + db * 4096 + (32 * hf + 16 * s) * 64;
                const s16x4 lo = vtr(p), hi = vtr(p + 512);
                const bf16x8 vf = (bf16x8){lo[0], lo[1], lo[2], lo[3], hi[0], hi[1], hi[2], hi[3]};
                o[db] = __builtin_amdgcn_mfma_f32_32x32x16_bf16(vf, pf, o[db], 0, 0, 0);
            }
        }
    asm volatile("" ::: "memory");
}
__device__ __forceinline__ void store_o(bf16* orow  , const f32x16 (&o)[2], float sc, int h) {
#pragma unroll
    for (int db = 0; db < 2; ++db)
#pragma unroll
        for (int g = 0; g < 4; ++g) {
            v2u w; w.x = pg8::pk_bf16(o[db][4 * g] * sc, o[db][4 * g + 1] * sc); w.y = pg8::pk_bf16(o[db][4 * g + 2] * sc, o[db][4 * g + 3] * sc);
            *(v2u*)(orow + 32 * db + 8 * g + 4 * h) = w;
        }
}
template <bool DIAG>
__device__ __forceinline__ void sb_tile(f32x16 (&S)[2], float& R, int kv0, int t, int h, int lane) {
    const int dd = t - kv0 - 4 * h;
    float lf[2][16];
#pragma unroll
    for (int hf = 0; hf < 2; ++hf)
#pragma unroll
        for (int r = 0; r < 16; ++r) {
            const float z = S[hf][r];
            const float sp = fmaxf(z, 0.f) + LN2 * lg2(1.0f + ex2(-LOG2E * fabsf(z)));
            const bool valid = !DIAG || ((32 * hf + (r & 3) + 8 * (r >> 2)) < dd);
            lf[hf][r] = valid ? -sp : 0.f;
        }
    float pg[8], tot[8];
#pragma unroll
    for (int pi = 0; pi < 8; ++pi) { const int hf = pi >> 2, g = pi & 3;
        const float gs = (lf[hf][4 * g] + lf[hf][4 * g + 1]) + (lf[hf][4 * g + 2] + lf[hf][4 * g + 3]);
        pg[pi] = xchg32(gs, lane); tot[pi] = gs + pg[pi]; }
    float suf = R;
#pragma unroll
    for (int pi = 7; pi >= 0; --pi) { const int hf = pi >> 2, g = pi & 3;
        float a = suf + (h == 0 ? pg[pi] : 0.f);
        suf += tot[pi];
#pragma unroll
        for (int e = 3; e >= 0; --e) { const int r = 4 * g + e;
            a += lf[hf][r];
            const bool valid = !DIAG || ((32 * hf + (r & 3) + 8 * (r >> 2)) < dd);
            S[hf][r] = valid ? ex2(LOG2E * (S[hf][r] + a)) : 0.f; }
    }
    R = suf;
}
__device__ __forceinline__ void osm_tile(f32x16 (&S)[2], f32x16 (&o)[2], float& m_run, float& l_run, int lane) {
    float mq[4] = {S[0][0], S[0][1], S[0][2], S[0][3]};
#pragma unroll
    for (int hf = 0; hf < 2; ++hf)
#pragma unroll
        for (int r = 0; r < 16; ++r) mq[r & 3] = fmaxf(mq[r & 3], S[hf][r]);
    float mx = fmaxf(fmaxf(mq[0], mq[1]), fmaxf(mq[2], mq[3]));
    mx = fmaxf(mx, xchg32(mx, lane));
    const float mn = fmaxf(m_run, mx), al = ex2(m_run - mn);
    float sq[4] = {0.f, 0.f, 0.f, 0.f};
#pragma unroll
    for (int hf = 0; hf < 2; ++hf)
#pragma unroll
        for (int r = 0; r < 16; ++r) { const float p = ex2(S[hf][r] - mn); S[hf][r] = p; sq[r & 3] += p; }
    const float sum = (sq[0] + sq[1]) + (sq[2] + sq[3]);
    l_run = l_run * al + sum;
    if (__any(mn > m_run)) {
#pragma unroll
        for (int db = 0; db < 2; ++db)
#pragma unroll
            for (int r = 0; r < 16; ++r) o[db][r] *= al;
    }
    m_run = mn;
}

#ifndef SB_EARLY_EXIT
#define SB_EARLY_EXIT 1
#endif
constexpr float SB_CUT = -110.0f;

template <int MX>
__device__ __forceinline__ void unit_body(const bf16* qp, const bf16* kb, const bf16* vb, bf16* orow, LAS unsigned char* vimg, LAS const float* tab, const float* F,
                                          int ntile, int kv_first, int step, int t, int cdist0  , int lane,
                                          unsigned* ctr, unsigned ngw, unsigned& nidx) {
    const int trig = (MX == 0) ? (ntile > 1 ? 1 : 0) : ntile - 1; bool got = false;
    const int h = lane >> 5;
    f32x16 o[2]; o[0] = f32x16{}; o[1] = f32x16{};
    bf16x8 qf[4], kf[2][4], kn[2][4]; f32x16 S[2];
#pragma unroll
    for (int d0 = 0; d0 < 4; ++d0) qf[d0] = *(const bf16x8*)(qp + 16 * d0);
    dma_v(vimg, vb + (size_t)kv_first * QW);
    load_k(kf, kb + (size_t)kv_first * QW);
    float R = 0.f, m_run = -1e30f, l_run = 0.f;
    f32x4 fk[2][4], fkn[2][4];
    if (MX == 2) {
#pragma unroll
        for (int hf = 0; hf < 2; ++hf)
#pragma unroll
            for (int g = 0; g < 4; ++g) fk[hf][g] = *(const f32x4*)(F + kv_first + 32 * hf + 8 * g + 4 * h);
    }
    for (int j = 0; j < ntile; ++j) {
        if (j == trig) { if (lane == 0) nidx = ngw + atomicAdd(ctr, 1u); got = true; }
        const int kv0 = kv_first + j * step; const bool has_next = j + 1 < ntile;
        LAS unsigned char* vcur = vimg + (j & 1) * 8192; LAS unsigned char* vnext = vimg + ((j & 1) ^ 1) * 8192;
        asm volatile("s_waitcnt lgkmcnt(0)" ::: "memory");
        const int kvn = has_next ? kv0 + step : kv0;
        if (MX == 2) {
#pragma unroll
            for (int hf = 0; hf < 2; ++hf)
#pragma unroll
                for (int r = 0; r < 16; ++r) S[hf][r] = fk[hf][r >> 2][r & 3];
        } else if (MX == 1) {
            if (cdist0 - j >= 3) { const float bc = tab[256];
#pragma unroll
                for (int hf = 0; hf < 2; ++hf)
#pragma unroll
                    for (int r = 0; r < 16; ++r) S[hf][r] = bc;
            } else { const int relb = t - kv0 + 128 - 4 * h;
#pragma unroll
                for (int hf = 0; hf < 2; ++hf)
#pragma unroll
                    for (int r = 0; r < 16; ++r) { int ix = relb - (32 * hf + (r & 3) + 8 * (r >> 2)); ix = ix > 256 ? 256 : ix; S[hf][r] = tab[ix]; }
            }
        } else { S[0] = f32x16{}; S[1] = f32x16{}; }
        qk(S, kf, qf);
        __builtin_amdgcn_sched_barrier(0);
        dma_v(vnext, vb + (size_t)kvn * QW);
        load_k(kn, kb + (size_t)kvn * QW);
        if (MX == 2) {
#pragma unroll
            for (int hf = 0; hf < 2; ++hf)
#pragma unroll
                for (int g = 0; g < 4; ++g) fkn[hf][g] = *(const f32x4*)(F + kvn + 32 * hf + 8 * g + 4 * h);
        }
        __builtin_amdgcn_sched_barrier(0);
        if (MX == 0) {
            if (j == 0) sb_tile<true>(S, R, kv0, t, h, lane); else sb_tile<false>(S, R, kv0, t, h, lane);
        } else if (MX == 2) {
            if (!has_next) {
                const int dd = t - kv0 - 4 * h;
#pragma unroll
                for (int hf = 0; hf < 2; ++hf)
#pragma unroll
                    for (int r = 0; r < 16; ++r) if ((32 * hf + (r & 3) + 8 * (r >> 2)) > dd) S[hf][r] = -1e30f;
            }
            osm_tile(S, o, m_run, l_run, lane);
        } else {
            osm_tile(S, o, m_run, l_run, lane);
        }
        if (MX == 2) asm volatile("s_waitcnt vmcnt(24)" ::: "memory"); else asm volatile("s_waitcnt vmcnt(16)" ::: "memory");
        pv(o, vcur, lane, S);
#if SB_EARLY_EXIT
        if (MX == 0) { if (__all(R < SB_CUT)) break; }
#endif
#pragma unroll
        for (int hf = 0; hf < 2; ++hf)
#pragma unroll
            for (int d0 = 0; d0 < 4; ++d0) kf[hf][d0] = kn[hf][d0];
        if (MX == 2) {
#pragma unroll
            for (int hf = 0; hf < 2; ++hf)
#pragma unroll
                for (int g = 0; g < 4; ++g) fk[hf][g] = fkn[hf][g];
        }
    }
    if (!got) { if (lane == 0) nidx = ngw + atomicAdd(ctr, 1u); }
    asm volatile("s_waitcnt vmcnt(0) lgkmcnt(0)" ::: "memory");
    float sc = 1.0f;
    if (MX != 0) { l_run += xchg32(l_run, lane); sc = 1.0f / l_run; }
    store_o(orow, o, sc, h);
}

__device__ __forceinline__ void attn_mfma(const bf16* QKV, bf16* O, const float* fc, const float* rel, unsigned* ctr, LAS unsigned char* lds, int wave, int lane_in, unsigned mask, unsigned nunits) {
    const unsigned ngw = gridDim.x * NWAVES; bool first = true; unsigned nidx = 0;
    for (;;) {
        int lane = lane_in; asm volatile("" : "+v"(lane));
        LAS unsigned char* vimg = lds + wave * WLDS;
        LAS float* tab = (LAS float*)(vimg + 16384);
        const int r32 = lane & 31, h = lane >> 5;
        unsigned idx = 0;
        if (first) { idx = (unsigned)wave * gridDim.x + blockIdx.x; first = false; }
        else idx = __builtin_amdgcn_readfirstlane(nidx);
        if (idx >= nunits) break;
        int mixer, u;
        if (idx < 1664u) { mixer = 2; u = (int)idx; }
        else if (idx < 3712u) { mixer = 0; u = (int)idx - 1664; }
        else if (idx < 4096u) { mixer = 2; u = (int)idx - 2048; }
        else { mixer = 1; u = 0; }
        if (!((mask >> mixer) & 1u)) continue;
        if (mixer != 1) {
            const int qb = 63 - (u >> 5), bh = u & 31, b = bh >> 2, hd = bh & 3;
            const int t0 = 32 * qb, t = t0 + r32, kt_hi = t0 >> 6;
            const int qoff = (mixer == 0 ? 0 : 2304) + 64 * hd, koff = qoff + 256, voff = koff + 256;
            const bf16* base = QKV + (size_t)b * SEQ * QW;
            const bf16* qp = base + (size_t)t * QW + qoff + 8 * h;
            const bf16* kb = base + (size_t)r32 * QW + koff + 8 * h;
            const bf16* vb = base + (size_t)(lane >> 2) * QW + voff + 8 * (lane & 3);
            bf16* orow = O + ((size_t)b * SEQ + t) * DM + (mixer == 0 ? 0 : 768) + 64 * hd;
            if (mixer == 0) unit_body<0>(qp, kb, vb, orow, vimg, tab, nullptr, kt_hi + 1, 64 * kt_hi, -64, t, 0, lane, ctr, ngw, nidx);
            else unit_body<2>(qp, kb, vb, orow, vimg, tab, fc + (size_t)bh * SEQ, kt_hi + 1, 0, 64, t, 0, lane, ctr, ngw, nidx);
        } else {
            const int u = (int)(idx - 4096u), bh = u & 63, rb = u >> 6, b = bh >> 3, hd = bh & 7;
            const int t0 = 32 * rb, t = t0 + r32, c = rb >> 1;
            const bf16* base = QKV + (size_t)b * SEQ * QW;
            const int qoff = 768 + 64 * hd, koff = 1280 + 64 * hd, voff = 1792 + 64 * hd;
            asm volatile("" ::: "memory");
#pragma unroll
            for (int i = 0; i < 5; ++i) { const int j = lane + 64 * i; if (j < NREL) tab[j] = LOG2E * rel[j * 8 + hd]; }
            asm volatile("s_waitcnt lgkmcnt(0)" ::: "memory");
            const bf16* qp = base + (size_t)t * QW + qoff + 8 * h;
            const bf16* kb = base + (size_t)r32 * QW + koff + 8 * h;
            const bf16* vb = base + (size_t)(lane >> 2) * QW + voff + 8 * (lane & 3);
            bf16* orow = O + ((size_t)b * SEQ + t) * DM + 256 + 64 * hd;
            const int kc_lo = c >= 8 ? c - 8 : 0;
            unit_body<1>(qp, kb, vb, orow, vimg, tab, nullptr, c - kc_lo + 1, 64 * kc_lo, 64, t, c - kc_lo, lane, ctr, ngw, nidx);
        }
    }
}

constexpr int CB_D = 3, CB_NBUF = CB_D + 1;
constexpr int CB_TAB = CB_NBUF * 16384, CB_WORD = CB_TAB + 8 * 1280;
__device__ __forceinline__ void attn_b_coop(const bf16* QKV, bf16* O, const float* rel, unsigned* ctr, LAS unsigned char* lds, int wave, int lane_in, int tid) {
    bool first = true;
    for (;;) {
        int lane = lane_in; asm volatile("" : "+v"(lane));
        const int r32 = lane & 31, h = lane >> 5;
        if (tid == 0) { const unsigned uu = first ? blockIdx.x : gridDim.x + atomicAdd(ctr, 1u); *(volatile LAS unsigned*)(lds + CB_WORD) = uu; }
        first = false;
        asm volatile("s_waitcnt vmcnt(0) lgkmcnt(0)\n\ts_barrier" ::: "memory");
        const unsigned u = (unsigned)__builtin_amdgcn_readfirstlane((int)*(volatile LAS unsigned*)(lds + CB_WORD));
        if (u >= 512u) break;
        const int bh = (int)(u & 63u), grp = 7 - (int)(u >> 6), b = bh >> 3, hd = bh & 7;
        const int c0 = 4 * grp, c = c0 + (wave >> 1), rb = 2 * c + (wave & 1), t = 32 * rb + r32;
        const int kc_lo = c0 >= 8 ? c0 - 8 : 0, ntile = c0 + 3 - kc_lo + 1;
        const int my_lo = c >= 8 ? c - 8 : 0;
        const bf16* base = QKV + (size_t)b * SEQ * QW;
        const bf16* ksrc = base + (size_t)(64 * kc_lo + 32 * (wave >> 2) + r32) * QW + 1280 + 64 * hd + 16 * (wave & 3) + 8 * h;
        const bf16* vsrc = base + (size_t)(64 * kc_lo + 16 * (wave >> 1) + (lane >> 2)) * QW + 1792 + 64 * hd + 32 * (wave & 1) + 8 * (lane & 3);
        const unsigned lds0 = (unsigned)__builtin_amdgcn_readfirstlane((int)(unsigned)(uintptr_t)lds);
        const unsigned kdst = lds0 + (unsigned)wave * 1024u, vdst = lds0 + 8192u + (unsigned)((wave & 1) * 4096 + (wave >> 1) * 1024);
#define CB_ISSUE(jj) do { const int jc_ = (jj) < ntile ? (jj) : ntile - 1; const unsigned bo_ = (unsigned)((jj) % CB_NBUF) * 16384u; \
        glds16(ksrc + (size_t)(64 * jc_) * QW, kdst + bo_); glds16(vsrc + (size_t)(64 * jc_) * QW, vdst + bo_); } while (0)
#pragma unroll
        for (int jj = 0; jj < CB_D; ++jj) CB_ISSUE(jj);
        const bf16* qp = base + (size_t)t * QW + 768 + 64 * hd + 8 * h;
        bf16x8 qf[4];
#pragma unroll
        for (int d0 = 0; d0 < 4; ++d0) qf[d0] = *(const bf16x8*)(qp + 16 * d0);
        LAS float* tab = (LAS float*)(lds + CB_TAB + wave * 1280);
#pragma unroll
        for (int i = 0; i < 5; ++i) { const int j = lane + 64 * i; if (j < NREL) tab[j] = LOG2E * rel[j * 8 + hd]; }
        asm volatile("s_waitcnt vmcnt(0)" :: "v"(qf[0]), "v"(qf[1]), "v"(qf[2]), "v"(qf[3]) : "memory");
        f32x16 o[2]; o[0] = f32x16{}; o[1] = f32x16{};
        float m_run = -1e30f, l_run = 0.f;
        for (int j = 0; j < ntile; ++j) {
            const int kc = kc_lo + j, kv0 = 64 * kc;
            const unsigned bo = (unsigned)(j % CB_NBUF) * 16384u;
            asm volatile("s_waitcnt vmcnt(4) lgkmcnt(0)\n\ts_barrier" ::: "memory");
            CB_ISSUE(j + CB_D);
            if (kc >= my_lo && kc <= c) {
                LAS unsigned char* kimg = lds + bo; LAS unsigned char* vimg = lds + bo + 8192;
                bf16x8 kf[2][4]; f32x16 S[2];
#pragma unroll
                for (int hf = 0; hf < 2; ++hf)
#pragma unroll
                    for (int d0 = 0; d0 < 4; ++d0) kf[hf][d0] = *(const LAS bf16x8*)(kimg + (hf * 4 + d0) * 1024 + 16 * lane);
                if (c - kc >= 3) {
                    const float bc = tab[256];
#pragma unroll
                    for (int hf = 0; hf < 2; ++hf)
#pragma unroll
                        for (int r = 0; r < 16; ++r) S[hf][r] = bc;
                } else {
                    const int relb = t - kv0 + 128 - 4 * h;
#pragma unroll
                    for (int hf = 0; hf < 2; ++hf)
#pragma unroll
                        for (int r = 0; r < 16; ++r) { int ix = relb - (32 * hf + (r & 3) + 8 * (r >> 2)); ix = ix > 256 ? 256 : ix; S[hf][r] = tab[ix]; }
                }
                qk(S, kf, qf);
                osm_tile(S, o, m_run, l_run, lane);
                pv(o, vimg, lane, S);
            }
        }
#undef CB_ISSUE
        l_run += xchg32(l_run, lane);
        store_o(O + ((size_t)b * SEQ + t) * DM + 256 + 64 * hd, o, 1.0f / l_run, h);
    }
}
}

#define XB_TMO      128
#define XB_XCNT(j)  (256  + 64 * (j))
#define XB_XSUB(j)  (1280 + 64 * (j))
#define XB_XGEN(j)  (2304 + 64 * (j))
#define XB_TOP      3328
#define XB_TOPGEN   3392
#define XCD_BAR_WORDS 3456
#define XB_SPIN_CAP (1u << 18)
__device__ __forceinline__ unsigned xb_ld(unsigned* p)              { return __hip_atomic_load(p, __ATOMIC_RELAXED, __HIP_MEMORY_SCOPE_AGENT); }
__device__ __forceinline__ unsigned xb_add(unsigned* p, unsigned v) { return __hip_atomic_fetch_add(p, v, __ATOMIC_RELAXED, __HIP_MEMORY_SCOPE_AGENT); }
__device__ __forceinline__ unsigned xb_xcc_id() { return (unsigned)__builtin_amdgcn_s_getreg((3 << 11) | 20) & 0xFu; }
#define XB_SPIN(cond, bar) do { unsigned _sp = 0; while (cond) { __builtin_amdgcn_s_sleep(1); \
    if ((++_sp & 255u) == 0u) { if (xb_ld(&(bar)[XB_TMO])) break; if (_sp > XB_SPIN_CAP) { atomicAdd(&(bar)[XB_TMO], 1u); break; } } } } while (0)
struct XcdBarrier { unsigned* bar; unsigned x; volatile LAS unsigned* st; };
__device__ __forceinline__ XcdBarrier xcd_barrier_post(unsigned* bar, volatile LAS unsigned* st) {
    XcdBarrier b; b.bar = bar; b.x = xb_xcc_id(); b.st = st;
    if (threadIdx.x == 0) (void)xb_add(&bar[XB_XCNT(b.x)], 1u);
    return b;
}
__device__ __forceinline__ void xcd_barrier_complete(unsigned* bar, unsigned x, unsigned& nloc, unsigned& nx) {
    const unsigned G = gridDim.x * gridDim.y * gridDim.z;
    unsigned sum, cnt, mine, sp = 0u;
    for (;;) {
        sum = 0u; cnt = 0u; mine = 0u;
#pragma unroll
        for (unsigned j = 0; j < 16; ++j) { const unsigned c = xb_ld(&bar[XB_XCNT(j)]); sum += c; cnt += (c > 0u) ? 1u : 0u; mine = (j == x) ? c : mine; }
        if (sum == G) break;
        __builtin_amdgcn_s_sleep(1);
        if ((++sp & 255u) == 0u) { if (xb_ld(&bar[XB_TMO])) break; if (sp > XB_SPIN_CAP) { atomicAdd(&bar[XB_TMO], 1u); break; } }
    }
    nloc = mine > 0u ? mine : 1u; nx = cnt > 0u ? cnt : 1u;
}
__device__ __forceinline__ void xcd_barrier(const XcdBarrier& b) {
    asm volatile("s_waitcnt vmcnt(0)" ::: "memory");
    __syncthreads();
    if (threadIdx.x == 0) {
        unsigned* bar = b.bar;
        __builtin_amdgcn_s_waitcnt(0);
        unsigned nloc = b.st[0], nx = b.st[1];
        if (nloc == 0u) { xcd_barrier_complete(bar, b.x, nloc, nx); b.st[0] = nloc; b.st[1] = nx; }
        const unsigned old = xb_add(&bar[XB_XSUB(b.x)], 1u);
        const unsigned gen = old / nloc;
        if (old + 1u == (gen + 1u) * nloc) {
            __builtin_amdgcn_fence(__ATOMIC_RELEASE, "agent");
            asm volatile("s_waitcnt vmcnt(0)" ::: "memory");
            const unsigned og = xb_add(&bar[XB_TOP], 1u);
            const unsigned tg = og / nx;
            if (og + 1u == (tg + 1u) * nx) xb_add(&bar[XB_TOPGEN], 1u);
            else XB_SPIN(xb_ld(&bar[XB_TOPGEN]) == tg, bar);
            __builtin_amdgcn_fence(__ATOMIC_ACQUIRE, "agent");
            xb_add(&bar[XB_XGEN(b.x)], 1u);
            asm volatile("s_waitcnt vmcnt(0)" ::: "memory");
        } else {
            XB_SPIN(xb_ld(&bar[XB_XGEN(b.x)]) == gen, bar);
            __builtin_amdgcn_fence(__ATOMIC_ACQUIRE, "agent");
            asm volatile("s_waitcnt vmcnt(0)" ::: "memory");
        }
    }
    __syncthreads();
}

constexpr int N_PHASES = 17;

__global__ void __launch_bounds__(NWAVES * 64, 2) mk_fwd(Args a) {
    extern __shared__ __attribute__((aligned(16))) unsigned char lds_raw[];
    LAS unsigned char* lds = (LAS unsigned char*)lds_raw;
    const int G = gridDim.x, bx = blockIdx.x, NGW = G * NWAVES;
    { LAS unsigned long long* tab = (LAS unsigned long long*)(lds + PTAB_OFF); const int t0 = threadIdx.x;
      if (t0 < 16) tab[t0] = (unsigned long long)a.in[t0];
      if (t0 == 16) tab[16] = (unsigned long long)a.out;
      if (t0 == 17) tab[17] = (unsigned long long)a.ws;
      if (t0 == 18) { ((LAS unsigned*)(lds + PTAB_OFF + 192))[0] = 0u; ((LAS unsigned*)(lds + PTAB_OFF + 192))[1] = 0u; } }
    __syncthreads();
    const XcdBarrier xbar = xcd_barrier_post((unsigned*)(a.ws + WS_CTL) + CW_BAR, (volatile LAS unsigned*)(lds + PTAB_OFF + 192));
    if (a.ph_lo < 0) cg::this_grid().sync();
    const int ph_lo = a.ph_lo, ph_hi = a.ph_hi;
#define PTR(i) ((const float*)(GAS_ const float*)ld_ptr(lds, (i)))
#define PH_BEGIN \
        int tid_ = threadIdx.x; asm volatile("" : "+v"(tid_)); \
        const int tid = tid_, lane = tid & 63, wave = __builtin_amdgcn_readfirstlane(tid >> 6); \
        const int gw = bx * NWAVES + wave; (void)gw; (void)lane; \
        LAS float* scr = (LAS float*)(lds + wave * 16384); (void)scr; \
        unsigned char* ws = (unsigned char*)(GAS_ unsigned char*)ld_ptr(lds, 17); \
        float* X = (float*)(GAS_ float*)ld_ptr(lds, 16); (void)X; \
        bf16* XN = (bf16*)(ws + WS_XN); bf16* QKV = (bf16*)(ws + WS_R1); bf16* GT = (bf16*)(ws + WS_R2); bf16* HB = (bf16*)(ws + WS_R2); \
        bf16* MG = (bf16*)(ws + WS_MERGED); float* TB = (float*)(ws + WS_T); float* PART = (float*)(ws + WS_PART); float* PARTD = (float*)(ws + WS_PARTD); float* FC = (float*)(ws + WS_FC); \
        (void)XN; (void)QKV; (void)GT; (void)HB; (void)MG; (void)TB; (void)PART; (void)PARTD; (void)FC;
#define IN(k) (ph_lo <= (k) && (k) < ph_hi)
#define SEAM(k) do { if (IN(k) && IN((k) + 1)) xcd_barrier(xbar); } while (0)

    if (IN(0)) { PH_BEGIN
        conv_ffn(lds, ws, 0, 0, 0, scr, gw, NGW, lane, 1);
        rows_raw(PTR(0), XN, PART, gw, NGW, lane);
    }
    SEAM(0);
#define LAYER(L, P0) \
    if (IN(P0)) { PH_BEGIN const bf16* w = (const bf16*)(ws + WS_T + (size_t)(L == 0 ? 0 : 2) * FFN_SLOT); \
        pg8::Gemm g{XN, w}; pg8::StaticOrder S; S.init(M, 2 * DFF, G, bx); pg8::EpiSwiglu E{HB, DFF, PART}; \
        for (int rep = 0; rep <= PROBE_G1; ++rep) pg8::gemm_phase<pg8::EpiSwiglu, pg8::StaticOrder, DM, DM, DM>(lds, g, S, E); \
        {     \
            const int nidle = G - (1408 % G); \
            if (1408 % G != 0 && bx >= 1408 % G) { if (L == 0) conv_ffn(lds, ws, 0, 0, 0, scr, (bx - 1408 % G) * NWAVES + wave, nidle * NWAVES, lane, 2); \
                                                    conv_mix(lds, ws, L, scr, (bx - 1408 % G) * NWAVES + wave, nidle * NWAVES, lane, L == 0 ? 1408 : 0); } \
            else if (1408 % G == 0) { if (L == 0) conv_ffn(lds, ws, 0, 0, 0, scr, gw, NGW, lane, 2); conv_mix(lds, ws, L, scr, gw, NGW, lane, L == 0 ? 1408 : 0); } } } \
    SEAM(P0); \
    if (IN(P0 + 1)) { PH_BEGIN const bf16* w = (const bf16*)(ws + WS_T + (size_t)(L == 0 ? 0 : 2) * FFN_SLOT + FFN_SLOT_OUT); \
        pg8::Gemm g{HB, w}; pg8::StaticOrder S; S.init(M, DM, G, bx); \
        pg8::EpiResid E{XN, X, XN, PART, PARTD, PTR(5) + (size_t)L * DM * INW, PTR(4) + L * DM, nullptr, nullptr, 0.5f}; \
        pg8::gemm_phase<pg8::EpiResid, pg8::StaticOrder, DFF, DFF, DFF>(lds, g, S, E); } \
    SEAM(P0 + 1); \
    if (IN(P0 + 2)) { PH_BEGIN if (bx < 32) cumsum_seq(PART, PARTD, PTR(6) + L * INW + QW, FC, bx, (LAS float*)lds, tid); \
        const bf16* w = (const bf16*)(ws + WS_WMIX + (size_t)L * WMIX_LAYER); \
        pg8::Gemm g{XN, w}; pg8::StaticOrder S; S.init(M, 2 * QW, G, bx); pg8::EpiQKVG E{QKV, GT, PTR(6) + L * INW, PART}; \
        pg8::gemm_phase<pg8::EpiQKVG, pg8::StaticOrder, DM, DM, DM>(lds, g, S, E); } \
    SEAM(P0 + 2); \
    if (IN(P0 + 3)) { PH_BEGIN \
        att::attn_b_coop(QKV, (bf16*)X, PTR(7) + L * NREL * 8, (unsigned*)(ws + WS_CTL) + 4 + L, lds, wave, lane, tid); \
        if (PROBE_ATT == 1) att::attn_b_coop(QKV, (bf16*)X, PTR(7) + L * NREL * 8, (unsigned*)(ws + WS_CTL) + 6 + L, lds, wave, lane, tid); \
        att::attn_mfma(QKV, (bf16*)X, FC, PTR(7) + L * NREL * 8, (unsigned*)(ws + WS_CTL) + L, lds, wave, lane, 5u, 4096u); \
        if (PROBE_ATT == 2) att::attn_mfma(QKV, (bf16*)X, FC, PTR(7) + L * NREL * 8, (unsigned*)(ws + WS_CTL) + 2 + L, lds, wave, lane, 5u, 4096u); \
        if (PROBE_ATT == 3) att::attn_mfma(QKV, (bf16*)X, FC, PTR(7) + L * NREL * 8, (unsigned*)(ws + WS_CTL) + 2 + L, lds, wave, lane, 1u, 2048u); \
        if (7u & ~MFMA_MASK) attn_naive(QKV, (bf16*)X, FC, PTR(7) + L * NREL * 8, gw, NGW, lane, 7u & ~MFMA_MASK); } \
    SEAM(P0 + 3); \
    if (IN(P0 + 4)) { PH_BEGIN const bf16* w = (const bf16*)(ws + WS_WMIX + (size_t)L * WMIX_LAYER + WMIX_BR); \
        pg8::StaticOrder S; S.init(M, DM, G, bx); \
        { pg8::Gemm g{(const bf16*)X, w}; pg8::EpiBranch1 E{GT, MG}; pg8::gemm_phase<pg8::EpiBranch1, pg8::StaticOrder, DM, DM, DM>(lds, g, S, E); } } \
    SEAM(P0 + 4); \
    if (IN(P0 + 5)) { PH_BEGIN \
        if (L == 0) conv_ffn(lds, ws, 0, 1, 1, scr, gw, NGW, lane); \
        else conv_ffn(lds, ws, 1, 1, 0, scr, gw, NGW, lane, 1); \
        __syncthreads(); \
        const bf16* w = (const bf16*)(ws + WS_WMIX + (size_t)L * WMIX_LAYER + WMIX_OUT); \
        pg8::Gemm g{MG, w}; pg8::StaticOrder S; S.init(M, DM, G, bx); pg8::EpiResid E{XN, X, XN, PART, nullptr, nullptr, nullptr, nullptr, nullptr, 1.0f}; \
        pg8::gemm_phase<pg8::EpiResid, pg8::StaticOrder, DM, DM, DM>(lds, g, S, E); } \
    SEAM(P0 + 5); \
    if (IN(P0 + 6)) { PH_BEGIN const bf16* w = (const bf16*)(ws + WS_T + (size_t)(L == 0 ? 1 : 0) * FFN_SLOT); \
        pg8::Gemm g{XN, w}; pg8::StaticOrder S; S.init(M, 2 * DFF, G, bx); pg8::EpiSwiglu E{HB, DFF, PART}; \
        pg8::gemm_phase<pg8::EpiSwiglu, pg8::StaticOrder, DM, DM, DM>(lds, g, S, E); \
        if (L == 0) {     \
            const int nidle = G - (1408 % G); \
            if (1408 % G != 0 && bx >= 1408 % G) conv_ffn(lds, ws, 1, 0, 2, scr, (bx - 1408 % G) * NWAVES + wave, nidle * NWAVES, lane); \
            else if (1408 % G == 0) conv_ffn(lds, ws, 1, 0, 2, scr, gw, NGW, lane); } \
        else {     \
            const int nidle = G - (1408 % G); \
            if (1408 % G != 0 && bx >= 1408 % G) conv_ffn(lds, ws, 1, 1, 0, scr, (bx - 1408 % G) * NWAVES + wave, nidle * NWAVES, lane, 2); \
            else if (1408 % G == 0) conv_ffn(lds, ws, 1, 1, 0, scr, gw, NGW, lane, 2); } } \
    SEAM(P0 + 6); \
    if (IN(P0 + 7)) { PH_BEGIN const bf16* w = (const bf16*)(ws + WS_T + (size_t)(L == 0 ? 1 : 0) * FFN_SLOT + FFN_SLOT_OUT); \
        pg8::Gemm g{HB, w}; pg8::StaticOrder S; S.init(M, DM, G, bx); pg8::EpiResid E{XN, X, L == 1 ? nullptr : XN, PART, nullptr, nullptr, nullptr, L == 1 ? PTR(15) : nullptr, (unsigned*)(ws + WS_CTL) + CW_PANEL, 0.5f}; \
        pg8::gemm_phase<pg8::EpiResid, pg8::StaticOrder, DFF, DFF, DFF>(lds, g, S, E); } \
    SEAM(P0 + 7);

    LAYER(0, 1)
    LAYER(1, 9)
    for (int rep = 0; rep < PROBE_SYNC; ++rep) xcd_barrier(xbar);
}

extern "C" void kernel_launch(void* const* d_in, const int* in_sizes, int n_in, void* d_out, int out_size, void* d_ws, size_t ws_size, hipStream_t stream) {
    static int grid = 0;
    if (grid == 0) {
        if (n_in != 16 || out_size != M * DM || ws_size < WS_END) { fprintf(stderr, "kernel_launch: unexpected shapes (n_in %d out %d ws %zu)\n", n_in, out_size, ws_size); grid = -1; return; }
        int dev = 0, cus = 0, per_cu = 0;
        (void)hipGetDevice(&dev);
        (void)hipDeviceGetAttribute(&cus, hipDeviceAttributeMultiprocessorCount, dev);
        (void)hipFuncSetAttribute((const void*)mk_fwd, hipFuncAttributeMaxDynamicSharedMemorySize, LDS_BYTES);
        (void)hipOccupancyMaxActiveBlocksPerMultiprocessor(&per_cu, (const void*)mk_fwd, NWAVES * 64, LDS_BYTES);
        if (per_cu < 1) per_cu = 1;
        grid = cus * per_cu;
        if (grid > 256) grid = 256;
        (void)hipGetLastError();
    }
    if (grid < 0) return;
    (void)hipMemsetAsync((char*)d_ws + WS_CTL, 0, 64 * 1024, stream);
    Args a{};
    for (int i = 0; i < 16; ++i) a.in[i] = (const float*)d_in[i];
    a.out = (float*)d_out; a.ws = (unsigned char*)d_ws;
#if MULTI_LAUNCH
    for (int ph = 0; ph < N_PHASES; ++ph) { a.ph_lo = ph; a.ph_hi = ph + 1; hipLaunchKernelGGL(mk_fwd, dim3(grid), dim3(NWAVES * 64), LDS_BYTES, stream, a); }
#else
    a.ph_lo = 0; a.ph_hi = N_PHASES;
    void* args[] = {&a};
    hipError_t e = hipLaunchCooperativeKernel((const void*)mk_fwd, dim3(grid), dim3(NWAVES * 64), args, LDS_BYTES, stream);
    if (e != hipSuccess) fprintf(stderr, "cooperative launch failed: %s (grid %d)\n", hipGetErrorString(e), grid);
#endif
}
```

```cpp
#include <hip/hip_runtime.h>
#include <hip/hip_cooperative_groups.h>
#include <cstdio>
#include <cstdint>
namespace cg = cooperative_groups;

#ifndef MFMA_MASK
#define MFMA_MASK 7u
#endif
#ifndef PROBE_ATT
#define PROBE_ATT 0
#endif
#ifndef PROBE_G1
#define PROBE_G1 0
#endif
#ifndef PROBE_SYNC
#define PROBE_SYNC 0
#endif
#ifndef MULTI_LAUNCH
#define MULTI_LAUNCH 0
#endif

namespace pg8 {
#define PG8_LAS __attribute__((address_space(3)))
typedef unsigned short bf16_t;
typedef short bf16x8 __attribute__((ext_vector_type(8)));
typedef float f32x4 __attribute__((ext_vector_type(4)));
typedef unsigned u32x4 __attribute__((ext_vector_type(4)));
typedef unsigned u32x2 __attribute__((ext_vector_type(2)));
constexpr int BM = 256, BK = 64, HALF = 128, HTB = HALF * BK * 2, STAGE_BYTES = 8 * HTB, NXCD = 8, WGM = 8;

__host__ __device__ __forceinline__ int lds_byte(int r, int c) { const int st = (r >> 4) * 2 + (c >> 5), rr = r & 15, cc = c & 31, ob = rr * 64 + cc * 2; return st * 1024 + (ob ^ (((ob >> 9) & 1) << 5)); }
__host__ __device__ __forceinline__ void stage_rc(int b, int& R, int& C) { const int st = b / 1024, sb = b % 1024, swz = sb ^ (((sb >> 9) & 1) << 5); R = (st >> 1) * 16 + swz / 64; C = (st & 1) * 32 + (swz % 64) / 2; }
__host__ __device__ __forceinline__ int perm32(int rho) { const int n = rho >> 4, i = rho & 15; return 8 * (i >> 2) + 4 * n + (i & 3); }

struct Unit { int pm, pn; };
struct Gemm { const bf16_t* A; const bf16_t* Bt; };

struct StaticOrder {
    int nM, nN, nwg, G, c;
    __host__ __device__ void init(int M, int N, int G_, int c_) { nM = M / BM; nN = N / BM; nwg = nM * nN; G = G_; c = c_; }
    __host__ __device__ bool next(int i, Unit& u) const {
        const long L = (long)i * G + c; if (L >= nwg) return false;
        int wgid = (int)L; { const int q = nwg / NXCD, r = nwg % NXCD, xcd = wgid % NXCD, off = wgid / NXCD; wgid = (xcd < r ? xcd * (q + 1) : r * (q + 1) + (xcd - r) * q) + off; }
        const int nig = WGM * nN, gid = wgid / nig, fm = gid * WGM, gsz = (nM - fm) < WGM ? (nM - fm) : WGM;
        u.pm = fm + ((wgid % nig) % gsz); u.pn = (wgid % nig) / gsz; return true;
    }
};

__device__ __forceinline__ unsigned pk_bf16(float lo, float hi) {
    typedef float f2 __attribute__((ext_vector_type(2))); typedef __bf16 b2 __attribute__((ext_vector_type(2)));
    f2 v = {lo, hi}; b2 b = __builtin_convertvector(v, b2); return __builtin_bit_cast(unsigned, b);
}
__device__ __forceinline__ float bf_lo(unsigned w) { return __uint_as_float(w << 16); }
__device__ __forceinline__ float bf_hi(unsigned w) { return __uint_as_float(w & 0xffff0000u); }
__device__ __forceinline__ float fast_sigmoid(float v) { return __builtin_amdgcn_rcpf(1.0f + __builtin_amdgcn_exp2f(-1.4426950408889634f * v)); }

constexpr int MROWS = 16384;
__device__ __forceinline__ float row_rstd(const float* part, int row) {
    const float ss = (part[row] + part[MROWS + row]) + (part[2 * MROWS + row] + part[3 * MROWS + row]);
    return 1.0f / sqrtf(ss * (1.0f / 1024.0f) + 1e-6f);
}
struct EpiSwiglu {
    static constexpr bool PERM = true, AFTER_DRAIN = false, RSTD = true, RESCALE = false, BIAS = false;
    bf16_t* H; int ldh; const float* part;
    __device__ __forceinline__ void operator()(const f32x4 (&acc)[2][2][4][2], const Unit& u, int wr, int wc, int fr, int fq, const PG8_LAS float* rsl) const {
        const int row0 = u.pm * BM + wr * 64 + fr, col0 = u.pn * HALF + wc * 32 + 8 * fq;
#pragma unroll
        for (int ai = 0; ai < 2; ++ai)
#pragma unroll
            for (int m = 0; m < 4; ++m) {
                bf16_t* p = H + (size_t)(row0 + ai * HALF + m * 16) * ldh + col0;
                const float rs = rsl[ai * HALF + wr * 64 + m * 16 + fr];
                float h[8];
#pragma unroll
                for (int n = 0; n < 2; ++n)
#pragma unroll
                    for (int e = 0; e < 4; ++e) { const float g = rs * acc[ai][0][m][n][e], up = rs * acc[ai][1][m][n][e]; h[n * 4 + e] = g * fast_sigmoid(g) * up; }
                u32x4 w; w.x = pk_bf16(h[0], h[1]); w.y = pk_bf16(h[2], h[3]); w.z = pk_bf16(h[4], h[5]); w.w = pk_bf16(h[6], h[7]);
                *(u32x4*)p = w;
            }
    }
};
struct EpiResid {
    static constexpr bool PERM = true, AFTER_DRAIN = true, RSTD = false, RESCALE = false;
    const bf16_t* base; float* out; bf16_t* xb; float* part; float* partd; const float* wf; const float* gmix; const float* gfin; unsigned* cnt; float scale;
    __device__ __forceinline__ void fused(f32x4 (&acc)[2][2][4][2], const Unit& u, int wr, int wc, int fr, int fq, PG8_LAS unsigned char* lds, int tid) const {
        const int row0 = u.pm * BM + wr * 64 + fr, col0 = u.pn * BM + wc * 32 + 8 * fq;
#pragma unroll
        for (int ai = 0; ai < 2; ++ai)
#pragma unroll
            for (int m = 0; m < 4; ++m) {
                const size_t off = (size_t)(row0 + ai * HALF + m * 16) * 1024 + col0;
#pragma unroll
                for (int bj = 0; bj < 2; ++bj) {
                    const u32x4 bw = *(const u32x4*)(base + off + bj * HALF);
                    const f32x4 b0 = {bf_lo(bw.x), bf_hi(bw.x), bf_lo(bw.y), bf_hi(bw.y)}, b1 = {bf_lo(bw.z), bf_hi(bw.z), bf_lo(bw.w), bf_hi(bw.w)};
                    const f32x4 v0 = b0 + acc[ai][bj][m][0] * scale, v1 = b1 + acc[ai][bj][m][1] * scale;
                    if (xb) { u32x4 w; w.x = pk_bf16(v0[0], v0[1]); w.y = pk_bf16(v0[2], v0[3]); w.z = pk_bf16(v1[0], v1[1]); w.w = pk_bf16(v1[2], v1[3]);
                              *(u32x4*)(xb + off + bj * HALF) = w; }
                    acc[ai][bj][m][0] = v0; acc[ai][bj][m][1] = v1;
                }
                asm volatile("" ::: "memory");
            }
        if (!xb && !gfin) return;
        float ss[8], dd[8][4];
#pragma unroll
        for (int r = 0; r < 8; ++r) { ss[r] = 0.f; dd[r][0] = 0.f; dd[r][1] = 0.f; dd[r][2] = 0.f; dd[r][3] = 0.f; }
#pragma unroll
        for (int ai = 0; ai < 2; ++ai)
#pragma unroll
            for (int m = 0; m < 4; ++m)
#pragma unroll
                for (int bj = 0; bj < 2; ++bj)
#pragma unroll
                    for (int n = 0; n < 2; ++n) { const f32x4 v = acc[ai][bj][m][n]; ss[ai * 4 + m] += (v[0] * v[0] + v[1] * v[1]) + (v[2] * v[2] + v[3] * v[3]); }
        if (partd) {
#pragma unroll
            for (int bj = 0; bj < 2; ++bj)
#pragma unroll
                for (int n = 0; n < 2; ++n) {
#pragma unroll
                    for (int e = 0; e < 4; ++e) {
                        const int c = col0 + bj * HALF + 4 * n + e;
                        const f32x4 w4 = *(const f32x4*)(wf + (size_t)c * 6148 + 3072) * gmix[c];
#pragma unroll
                        for (int ai = 0; ai < 2; ++ai)
#pragma unroll
                            for (int m = 0; m < 4; ++m) { const float x = acc[ai][bj][m][n][e];
                                dd[ai * 4 + m][0] += x * w4[0]; dd[ai * 4 + m][1] += x * w4[1]; dd[ai * 4 + m][2] += x * w4[2]; dd[ai * 4 + m][3] += x * w4[3]; }
                    }
                    asm volatile("" ::: "memory");
                }
        }
        const int lane = tid & 63;
        PG8_LAS float* red = (PG8_LAS float*)lds;
#pragma unroll
        for (int r = 0; r < 8; ++r) {
            float v = ss[r];
            v += __int_as_float(__builtin_amdgcn_ds_bpermute((lane ^ 16) << 2, __float_as_int(v)));
            v += __int_as_float(__builtin_amdgcn_ds_bpermute((lane ^ 32) << 2, __float_as_int(v)));
            const int rl = (r >> 2) * HALF + wr * 64 + (r & 3) * 16 + fr;
            if (fq == 0) red[(rl * 4 + wc) * 5] = v;
            if (partd) {
#pragma unroll
                for (int hh = 0; hh < 4; ++hh) {
                    float d = dd[r][hh];
                    d += __int_as_float(__builtin_amdgcn_ds_bpermute((lane ^ 16) << 2, __float_as_int(d)));
                    d += __int_as_float(__builtin_amdgcn_ds_bpermute((lane ^ 32) << 2, __float_as_int(d)));
                    if (fq == 0) red[(rl * 4 + wc) * 5 + 1 + hh] = d;
                }
            }
        }
        asm volatile("s_waitcnt lgkmcnt(0)" ::: "memory"); __builtin_amdgcn_s_barrier(); asm volatile("" ::: "memory");
        if (gfin) {
            if (tid < 256) { const PG8_LAS float* rp = red + tid * 20; const int gm = u.pm * BM + tid;
                __hip_atomic_store(part + (size_t)u.pn * MROWS + gm, (rp[0] + rp[5]) + (rp[10] + rp[15]), __ATOMIC_RELAXED, __HIP_MEMORY_SCOPE_AGENT); }
            asm volatile("s_waitcnt vmcnt(0)" ::: "memory"); __builtin_amdgcn_s_barrier(); asm volatile("" ::: "memory");
            if (tid == 0) {
                __hip_atomic_fetch_add(cnt + 64 * u.pm, 1u, __ATOMIC_RELAXED, __HIP_MEMORY_SCOPE_AGENT);
                unsigned spins = 0;
                while (__hip_atomic_load(cnt + 64 * u.pm, __ATOMIC_RELAXED, __HIP_MEMORY_SCOPE_AGENT) < 4u) { __builtin_amdgcn_s_sleep(2); if (++spins > (1u << 22)) break; }
                __builtin_amdgcn_fence(__ATOMIC_ACQUIRE, "agent");
            }
            asm volatile("s_waitcnt vmcnt(0) lgkmcnt(0)" ::: "memory"); __builtin_amdgcn_s_barrier(); asm volatile("" ::: "memory");
            PG8_LAS float* rsf = red + 256 * 20;
            if (tid < 256) { const int gm = u.pm * BM + tid; float ssum = 0.f;
#pragma unroll
                for (int p4 = 0; p4 < 4; ++p4) ssum += __hip_atomic_load(part + (size_t)p4 * MROWS + gm, __ATOMIC_RELAXED, __HIP_MEMORY_SCOPE_AGENT);
                rsf[tid] = 1.0f / sqrtf(ssum * (1.0f / 1024.0f) + 1e-6f); }
            asm volatile("s_waitcnt vmcnt(0) lgkmcnt(0)" ::: "memory"); __builtin_amdgcn_s_barrier(); asm volatile("" ::: "memory");
            f32x4 gv[2][2];
#pragma unroll
            for (int bj = 0; bj < 2; ++bj)
#pragma unroll
                for (int n = 0; n < 2; ++n) gv[bj][n] = *(const f32x4*)(gfin + col0 + bj * HALF + 4 * n);
#pragma unroll
            for (int ai = 0; ai < 2; ++ai)
#pragma unroll
                for (int m = 0; m < 4; ++m) {
                    const float rs = rsf[ai * HALF + wr * 64 + m * 16 + fr];
                    const size_t off = (size_t)(row0 + ai * HALF + m * 16) * 1024 + col0;
#pragma unroll
                    for (int bj = 0; bj < 2; ++bj) {
                        *(f32x4*)(out + off + bj * HALF) = acc[ai][bj][m][0] * rs * gv[bj][0];
                        *(f32x4*)(out + off + bj * HALF + 4) = acc[ai][bj][m][1] * rs * gv[bj][1];
                    }
                }
            return;
        }
        if (tid < 256) {
            const PG8_LAS float* rp = red + tid * 20; const int gm = u.pm * BM + tid;
            part[(size_t)u.pn * MROWS + gm] = (rp[0] + rp[5]) + (rp[10] + rp[15]);
            if (partd) { f32x4 o;
#pragma unroll
                for (int hh = 0; hh < 4; ++hh) o[hh] = (rp[1 + hh] + rp[6 + hh]) + (rp[11 + hh] + rp[16 + hh]);
                *(f32x4*)(partd + ((size_t)u.pn * MROWS + gm) * 4) = o; }
        }
    }
};
struct EpiQKVG {
    static constexpr bool PERM = true, AFTER_DRAIN = false, RSTD = true, RESCALE = false, BIAS = true;
    bf16_t* QKV; bf16_t* G; const float* bias; const float* part;
    __device__ __forceinline__ void operator()(const f32x4 (&acc)[2][2][4][2], const Unit& u, int wr, int wc, int fr, int fq, const PG8_LAS float* rsl) const {
        const int row0 = u.pm * BM + wr * 64 + fr;
        const bool gate = u.pn >= 12;
        const int pnl = gate ? u.pn - 12 : u.pn;
        const int col0 = pnl * BM + wc * 32 + 8 * fq;
        const int bcol0 = u.pn * BM + wc * 32 + 8 * fq + (gate ? 4 : 0);
        bf16_t* dst = gate ? G : QKV;
        const bool isq = (u.pn == 0) || (u.pn == 3) || (u.pn == 4) || (u.pn == 9);
        const float sc = isq ? (u.pn == 0 ? 0.125f : 0.125f * 1.4426950408889634f) : 1.0f;
        float bv[2][8];
#pragma unroll
        for (int bj = 0; bj < 2; ++bj)
#pragma unroll
            for (int e = 0; e < 8; ++e) bv[bj][e] = rsl[2048 + bj * HALF + wc * 32 + 8 * fq + e];
        (void)bcol0;
#pragma unroll
        for (int ai = 0; ai < 2; ++ai)
#pragma unroll
            for (int m = 0; m < 4; ++m) {
                bf16_t* p = dst + (size_t)(row0 + ai * HALF + m * 16) * 3072 + col0;
                const float rs = rsl[ai * HALF + wr * 64 + m * 16 + fr];
#pragma unroll
                for (int bj = 0; bj < 2; ++bj) {
                    float v[8];
#pragma unroll
                    for (int n = 0; n < 2; ++n)
#pragma unroll
                        for (int e = 0; e < 4; ++e) { float t = rs * acc[ai][bj][m][n][e] + bv[bj][n * 4 + e]; v[n * 4 + e] = gate ? fast_sigmoid(t) : t * sc; }
                    u32x4 w; w.x = pk_bf16(v[0], v[1]); w.y = pk_bf16(v[2], v[3]); w.z = pk_bf16(v[4], v[5]); w.w = pk_bf16(v[6], v[7]);
                    *(u32x4*)(p + bj * HALF) = w;
                }
            }
    }
};
struct EpiBranch {
    static constexpr bool PERM = true, AFTER_DRAIN = false, RSTD = false, RESCALE = false;
    const bf16_t* G; float* T; bf16_t* merged; int mode;
    __device__ __forceinline__ void operator()(const f32x4 (&acc)[2][2][4][2], const Unit& u, int wr, int wc, int fr, int fq, const PG8_LAS float*) const {
        const int row0 = u.pm * BM + wr * 64 + fr, col0 = u.pn * BM + wc * 32 + 8 * fq;
#pragma unroll
        for (int ai = 0; ai < 2; ++ai)
#pragma unroll
            for (int m = 0; m < 4; ++m) {
                const size_t row = (size_t)(row0 + ai * HALF + m * 16);
#pragma unroll
                for (int bj = 0; bj < 2; ++bj) {
                    const u32x4 gw = *(const u32x4*)(G + row * 3072 + col0 + bj * HALF);
                    f32x4 v0, v1;
                    v0[0] = bf_lo(gw.x) * acc[ai][bj][m][0][0]; v0[1] = bf_hi(gw.x) * acc[ai][bj][m][0][1];
                    v0[2] = bf_lo(gw.y) * acc[ai][bj][m][0][2]; v0[3] = bf_hi(gw.y) * acc[ai][bj][m][0][3];
                    v1[0] = bf_lo(gw.z) * acc[ai][bj][m][1][0]; v1[1] = bf_hi(gw.z) * acc[ai][bj][m][1][1];
                    v1[2] = bf_lo(gw.w) * acc[ai][bj][m][1][2]; v1[3] = bf_hi(gw.w) * acc[ai][bj][m][1][3];
                    float* tp = T + row * 1024 + col0 + bj * HALF;
                    if (mode != 0) { v0 += *(const f32x4*)tp; v1 += *(const f32x4*)(tp + 4); }
                    if (mode != 2) { *(f32x4*)tp = v0; *(f32x4*)(tp + 4) = v1; }
                    else { u32x4 w; w.x = pk_bf16(v0[0], v0[1]); w.y = pk_bf16(v0[2], v0[3]); w.z = pk_bf16(v1[0], v1[1]); w.w = pk_bf16(v1[2], v1[3]);
                           *(u32x4*)(merged + row * 1024 + col0 + bj * HALF) = w; }
                }
                asm volatile("" ::: "memory");
            }
    }
};

struct EpiBranch1 {
    static constexpr bool PERM = true, AFTER_DRAIN = false, RSTD = false, RESCALE = true;
    const bf16_t* G; bf16_t* merged;
    static __device__ __forceinline__ float fl(float g) { return fmaxf(g, 1e-30f); }
    __device__ __forceinline__ void rescale(f32x4 (&acc)[2][2][4][2], const Unit& u, int wr, int wc, int fr, int fq, int from) const {
        const int row0 = u.pm * BM + wr * 64 + fr, col0 = u.pn * BM + wc * 32 + 8 * fq + from * 1024;
#pragma unroll
        for (int ai = 0; ai < 2; ++ai)
#pragma unroll
            for (int m = 0; m < 4; ++m) {
                const bf16_t* gp = G + (size_t)(row0 + ai * HALF + m * 16) * 3072 + col0;
#pragma unroll
                for (int bj = 0; bj < 2; ++bj) {
                    const u32x4 a = *(const u32x4*)(gp + bj * HALF), b = *(const u32x4*)(gp + bj * HALF + 1024);
                    acc[ai][bj][m][0][0] *= fl(bf_lo(a.x)) * __builtin_amdgcn_rcpf(fl(bf_lo(b.x))); acc[ai][bj][m][0][1] *= fl(bf_hi(a.x)) * __builtin_amdgcn_rcpf(fl(bf_hi(b.x)));
                    acc[ai][bj][m][0][2] *= fl(bf_lo(a.y)) * __builtin_amdgcn_rcpf(fl(bf_lo(b.y))); acc[ai][bj][m][0][3] *= fl(bf_hi(a.y)) * __builtin_amdgcn_rcpf(fl(bf_hi(b.y)));
                    acc[ai][bj][m][1][0] *= fl(bf_lo(a.z)) * __builtin_amdgcn_rcpf(fl(bf_lo(b.z))); acc[ai][bj][m][1][1] *= fl(bf_hi(a.z)) * __builtin_amdgcn_rcpf(fl(bf_hi(b.z)));
                    acc[ai][bj][m][1][2] *= fl(bf_lo(a.w)) * __builtin_amdgcn_rcpf(fl(bf_lo(b.w))); acc[ai][bj][m][1][3] *= fl(bf_hi(a.w)) * __builtin_amdgcn_rcpf(fl(bf_hi(b.w)));
                }
            }
    }
    __device__ __forceinline__ void operator()(const f32x4 (&acc)[2][2][4][2], const Unit& u, int wr, int wc, int fr, int fq, const PG8_LAS float*) const {
        const int row0 = u.pm * BM + wr * 64 + fr, col0 = u.pn * BM + wc * 32 + 8 * fq;
#pragma unroll
        for (int ai = 0; ai < 2; ++ai)
#pragma unroll
            for (int m = 0; m < 4; ++m) {
                const size_t row = (size_t)(row0 + ai * HALF + m * 16);
#pragma unroll
                for (int bj = 0; bj < 2; ++bj) {
                    const u32x4 g = *(const u32x4*)(G + row * 3072 + 2048 + col0 + bj * HALF);
                    u32x4 w;
                    w.x = pk_bf16(acc[ai][bj][m][0][0] * fl(bf_lo(g.x)), acc[ai][bj][m][0][1] * fl(bf_hi(g.x)));
                    w.y = pk_bf16(acc[ai][bj][m][0][2] * fl(bf_lo(g.y)), acc[ai][bj][m][0][3] * fl(bf_hi(g.y)));
                    w.z = pk_bf16(acc[ai][bj][m][1][0] * fl(bf_lo(g.z)), acc[ai][bj][m][1][1] * fl(bf_hi(g.z)));
                    w.w = pk_bf16(acc[ai][bj][m][1][2] * fl(bf_lo(g.w)), acc[ai][bj][m][1][3] * fl(bf_hi(g.w)));
                    *(u32x4*)(merged + row * 1024 + col0 + bj * HALF) = w;
                }
                if (m & 1) asm volatile("" ::: "memory");
            }
    }
};

template <class Epi, class Sched, int K_, int LDA_, int LDB_>
__device__ __forceinline__ void gemm_phase(PG8_LAS unsigned char* lds, const Gemm g, const Sched S, const Epi E) {
    int tid_ = threadIdx.x; asm volatile("" : "+v"(tid_));
    const int tid = tid_, wid = __builtin_amdgcn_readfirstlane(tid >> 6), lane = tid & 63, wr = wid >> 2, wc = wid & 3, fr = lane & 15, fq = lane >> 4;
    constexpr int nt = K_ / BK;
    unsigned voffA[2], voffB[2];
#pragma unroll
    for (int i = 0; i < 2; ++i) { int R, C; stage_rc(tid * 16 + i * 8192, R, C); const int Rb = Epi::PERM ? ((R & ~31) + perm32(R & 31)) : R;
        voffA[i] = (unsigned)(R * LDA_ + C) * 2u; voffB[i] = (unsigned)(Rb * LDB_ + C) * 2u; }
    constexpr size_t kstep = (size_t)(BK * 2);
    constexpr size_t hstepA = (size_t)HALF * LDA_ * 2, hstepB = (size_t)HALF * LDB_ * 2;
    constexpr size_t tstepA = 2 * hstepA, tstepB = 2 * hstepB;
    const unsigned ldsw = (unsigned)wid * 1024u;
    const int aoff = lds_byte(wr * 64 + fr, fq * 8), boff = lds_byte(wc * 32 + fr, fq * 8);
#define PG8_SA(b, h) (((b) * 2 + (h)) * HTB)
#define PG8_SB(b, h) ((4 + (b) * 2 + (h)) * HTB)
#define PG8_STAGE(bufoff, gbase, voff) do { _Pragma("unroll") for (int _i = 0; _i < 2; ++_i) \
        __builtin_amdgcn_global_load_lds((const unsigned*)((const char*)(gbase) + (voff)[_i]), (PG8_LAS unsigned*)(lds + (bufoff) + ldsw + _i * 8192), 16, 0, 0); } while (0)
#define PG8_LDA(dst, b, h) do { _Pragma("unroll") for (int m = 0; m < 4; ++m) _Pragma("unroll") for (int k = 0; k < 2; ++k) dst[m][k] = *(const PG8_LAS bf16x8*)(lds + PG8_SA(b, h) + aoff + m * 2048 + k * 1024); } while (0)
#define PG8_LDB(dst, b, h) do { _Pragma("unroll") for (int n = 0; n < 2; ++n) _Pragma("unroll") for (int k = 0; k < 2; ++k) dst[n][k] = *(const PG8_LAS bf16x8*)(lds + PG8_SB(b, h) + boff + n * 2048 + k * 1024); } while (0)
#define PG8_MMA(ai, bj, At, Bt) do { __builtin_amdgcn_s_setprio(1); _Pragma("unroll") for (int m = 0; m < 4; ++m) _Pragma("unroll") for (int n = 0; n < 2; ++n) _Pragma("unroll") for (int k = 0; k < 2; ++k) \
        acc[ai][bj][m][n] = __builtin_amdgcn_mfma_f32_16x16x32_bf16(Bt[n][k], At[m][k], acc[ai][bj][m][n], 0, 0, 0); __builtin_amdgcn_s_setprio(0); } while (0)
#define PG8_WAIT_V(n) asm volatile("s_waitcnt vmcnt(" #n ")" ::: "memory")
#define PG8_WAIT_L(n) asm volatile("s_waitcnt lgkmcnt(" #n ")" ::: "memory")
#define PG8_BAR __builtin_amdgcn_s_barrier()
#define PG8_SCHED __builtin_amdgcn_sched_barrier(0)
    Unit cur, nxt; int ui = 0;
    if (!S.next(0, cur)) return;
    PG8_LAS float* rsl = (PG8_LAS float*)(lds + STAGE_BYTES);
    f32x4 acc[2][2][4][2];
#pragma unroll
    for (int a = 0; a < 2; ++a)
#pragma unroll
        for (int b = 0; b < 2; ++b)
#pragma unroll
            for (int m = 0; m < 4; ++m)
#pragma unroll
                for (int n = 0; n < 2; ++n) acc[a][b][m][n] = (f32x4){0.f, 0.f, 0.f, 0.f};
    bf16x8 At[4][2], B0[2][2], B1[2][2];
    const char* cA = (const char*)g.A + (size_t)cur.pm * tstepA; const char* cB = (const char*)g.Bt + (size_t)cur.pn * tstepB;
    PG8_STAGE(PG8_SB(0, 0), cB, voffB); PG8_STAGE(PG8_SB(0, 1), cB + hstepB, voffB); PG8_STAGE(PG8_SA(0, 0), cA, voffA); PG8_STAGE(PG8_SA(0, 1), cA + hstepA, voffA);
    if constexpr (Epi::RSTD) {
        Unit uu;
        for (int i = 0; i < 8 && S.next(i, uu); ++i) if (tid < 256) {
            rsl[i * 256 + tid] = row_rstd(E.part, uu.pm * BM + tid);
            if constexpr (Epi::BIAS) { if (i < 6) rsl[2048 + i * 256 + tid] = E.bias[uu.pn * BM + tid + (uu.pn >= 12 ? 4 : 0)]; }
        }
        asm volatile("s_waitcnt lgkmcnt(0)" ::: "memory"); __builtin_amdgcn_s_barrier(); asm volatile("" ::: "memory");
    }
    if (wr == 1) PG8_BAR;
    PG8_WAIT_V(2); PG8_BAR;
    PG8_STAGE(PG8_SB(1, 0), cB + kstep, voffB); PG8_STAGE(PG8_SA(1, 0), cA + kstep, voffA); PG8_STAGE(PG8_SB(1, 1), cB + hstepB + kstep, voffB);
    PG8_WAIT_V(6); PG8_BAR;
    for (;;) {
        const bool has_next = S.next(ui + 1, nxt);
        const char* nA = has_next ? (const char*)g.A + (size_t)nxt.pm * tstepA : cA; const char* nB = has_next ? (const char*)g.Bt + (size_t)nxt.pn * tstepB : cB;
        for (int t = 0; t < nt; t += 2) {
            if constexpr (Epi::RESCALE) {
                if (t == 4 || t == 12) { int t3 = threadIdx.x; asm volatile("" : "+v"(t3)); const int l3 = t3 & 63; E.rescale(acc, cur, wr, wc, l3 & 15, l3 >> 4, t == 4 ? 0 : 1); }
            }
            const bool last = (t == nt - 2);
            const char* a1 = cA + (size_t)(t + 1) * kstep;
            const char* a2 = last ? nA : cA + (size_t)(t + 2) * kstep; const char* b2 = last ? nB : cB + (size_t)(t + 2) * kstep;
            const char* a3 = a2 + kstep; const char* b3 = b2 + kstep;
            PG8_LDB(B0, 0, 0); PG8_LDB(B1, 0, 1); PG8_SCHED; PG8_LDA(At, 0, 0); PG8_STAGE(PG8_SA(1, 1), a1 + hstepA, voffA);
            PG8_WAIT_V(8); PG8_WAIT_L(0); PG8_BAR; PG8_MMA(0, 0, At, B0); PG8_MMA(0, 1, At, B1); PG8_BAR; PG8_SCHED;
            PG8_LDA(At, 0, 1); PG8_STAGE(PG8_SB(0, 0), b2, voffB); PG8_STAGE(PG8_SB(0, 1), b2 + hstepB, voffB); PG8_STAGE(PG8_SA(0, 0), a2, voffA);
            PG8_WAIT_V(8); PG8_WAIT_L(0); PG8_BAR; PG8_MMA(1, 0, At, B0); PG8_MMA(1, 1, At, B1); PG8_BAR; PG8_SCHED;
            PG8_LDB(B0, 1, 0); PG8_LDB(B1, 1, 1); PG8_SCHED; PG8_LDA(At, 1, 0); PG8_STAGE(PG8_SA(0, 1), a2 + hstepA, voffA);
            PG8_WAIT_V(8); PG8_WAIT_L(0); PG8_BAR; PG8_MMA(0, 0, At, B0); PG8_MMA(0, 1, At, B1); PG8_BAR; PG8_SCHED;
            PG8_LDA(At, 1, 1); PG8_STAGE(PG8_SB(1, 0), b3, voffB); PG8_STAGE(PG8_SB(1, 1), b3 + hstepB, voffB); PG8_STAGE(PG8_SA(1, 0), a3, voffA);
            PG8_WAIT_V(8); PG8_WAIT_L(0); PG8_BAR; PG8_MMA(1, 0, At, B0); PG8_MMA(1, 1, At, B1); PG8_BAR; PG8_SCHED;
        }
        if (wr == 0) PG8_BAR;
        { int t2 = threadIdx.x; asm volatile("" : "+v"(t2));
          const int l2 = t2 & 63; if constexpr (!Epi::AFTER_DRAIN) E(acc, cur, wr, wc, l2 & 15, l2 >> 4, rsl + ui * 256); }
        if (!has_next) break;
#pragma unroll
        for (int a = 0; a < 2; ++a)
#pragma unroll
            for (int b = 0; b < 2; ++b)
#pragma unroll
                for (int m = 0; m < 4; ++m)
#pragma unroll
                    for (int n = 0; n < 2; ++n) acc[a][b][m][n] = (f32x4){0.f, 0.f, 0.f, 0.f};
        cur = nxt; cA = nA; cB = nB; ++ui;
        if (wr == 1) PG8_BAR;
    }
    PG8_WAIT_V(0);
    PG8_BAR;
    if constexpr (Epi::AFTER_DRAIN) { int t2 = threadIdx.x; asm volatile("" : "+v"(t2)); const int l2 = t2 & 63; E.fused(acc, cur, wr, wc, l2 & 15, l2 >> 4, lds, t2); PG8_BAR; }
#undef PG8_SA
#undef PG8_SB
#undef PG8_STAGE
#undef PG8_LDA
#undef PG8_LDB
#undef PG8_MMA
#undef PG8_WAIT_V
#undef PG8_WAIT_L
#undef PG8_BAR
#undef PG8_SCHED
}
}

typedef unsigned short bf16;
typedef float f32x4 __attribute__((ext_vector_type(4)));
typedef unsigned v4u __attribute__((ext_vector_type(4)));
typedef unsigned v2u __attribute__((ext_vector_type(2)));
#define LAS __attribute__((address_space(3)))
constexpr int DM = 1024, NB = 8, SEQ = 2048, M = NB * SEQ, DFF = 2816, INW = 6148, QW = 3072, NREL = 257;
constexpr int NWAVES = 8;
constexpr float RMS_EPS = 1e-6f;
constexpr float LOG2E = 1.4426950408889634f, LN2 = 0.6931471805599453f;

constexpr size_t MiB = 1u << 20;
constexpr size_t WS_CTL = 0;
constexpr int CW_BAR = 1024;
constexpr int CW_PANEL = 8192;
constexpr size_t WS_PART = 64 * 1024;
constexpr size_t WS_FC = WS_PART + 256 * 1024;
constexpr size_t WS_WMIX = 1 * MiB;
constexpr size_t WMIX_LAYER = 16 * MiB, WMIX_BR = 12 * MiB, WMIX_OUT = 14 * MiB;
constexpr size_t WS_XN = 33 * MiB;
constexpr size_t WS_R1 = 65 * MiB;
constexpr size_t WS_MERGED = WS_R1, WS_T = WS_R1 + 32 * MiB;
constexpr size_t FFN_SLOT = 17 * MiB, FFN_SLOT_OUT = 11 * MiB;
constexpr size_t WS_R2 = 161 * MiB;
constexpr size_t WS_PARTD = 257 * MiB;
constexpr size_t WS_END = 258 * MiB;
static_assert(WS_END <= 272000000ull, "workspace budget");
static_assert(3 * FFN_SLOT <= 64 * MiB, "ffn slots inside T");

constexpr int LDS_BYTES = 147456;

__device__ __forceinline__ unsigned f2bf(float f) { unsigned u = __builtin_bit_cast(unsigned, f); return (u + 0x7fffu + ((u >> 16) & 1u)) >> 16; }
__device__ __forceinline__ unsigned pk2(float lo, float hi) { return f2bf(lo) | (f2bf(hi) << 16); }
__device__ __forceinline__ float bf2f(bf16 v) { return __uint_as_float(((unsigned)v) << 16); }
__device__ __forceinline__ float wave_sum(float v, int lane) {
#pragma unroll
    for (int o = 1; o < 64; o <<= 1) v += __int_as_float(__builtin_amdgcn_ds_bpermute((lane ^ o) << 2, __float_as_int(v)));
    return v;
}

__device__ __forceinline__ void tr_item(const float* W, int N, int k0, int n0, bf16* WT, int ldt, int drow0, int dk0, LAS float* scr, int lane, const float* gk) {
    const int c4 = 4 * (lane & 7), r8 = lane >> 3;
    f32x4 v[8];
#pragma unroll
    for (int i = 0; i < 8; ++i) v[i] = __builtin_nontemporal_load((const f32x4*)(W + (size_t)(k0 + 8 * i + r8) * N + n0 + c4));
#pragma unroll
    for (int i = 0; i < 8; ++i) { LAS float* d = scr + (8 * i + r8) * 33 + c4; d[0] = v[i][0]; d[1] = v[i][1]; d[2] = v[i][2]; d[3] = v[i][3]; }
    asm volatile("s_waitcnt lgkmcnt(0)" ::: "memory");
    const int c = lane & 7;
    f32x4 ga = {1.f, 1.f, 1.f, 1.f}, gb = {1.f, 1.f, 1.f, 1.f};
    if (gk) { ga = *(const f32x4*)(gk + k0 + 8 * c); gb = *(const f32x4*)(gk + k0 + 8 * c + 4); }
#pragma unroll
    for (int j = 0; j < 4; ++j) { const int n = (lane >> 3) + 8 * j; const LAS float* s = scr + (8 * c) * 33 + n;
        v4u o; o.x = pk2(s[0 * 33] * ga[0], s[1 * 33] * ga[1]); o.y = pk2(s[2 * 33] * ga[2], s[3 * 33] * ga[3]); o.z = pk2(s[4 * 33] * gb[0], s[5 * 33] * gb[1]); o.w = pk2(s[6 * 33] * gb[2], s[7 * 33] * gb[3]);
        *(v4u*)(WT + (size_t)(drow0 + n) * ldt + dk0 + k0 + 8 * c) = o; }
    asm volatile("s_waitcnt lgkmcnt(0)" ::: "memory");
}
__device__ __forceinline__ void conv_matrix(const float* W, int K, int N, int nblk, int kind, bf16* WT, int ldt, int dk0, LAS float* scr, int gw, int NGW, int lane, const float* gk = nullptr, int off = 0) {
    const int nitems = (K / 64) * nblk;
    for (int it = (gw + NGW - off % NGW) % NGW; it < nitems; it += NGW) {
        const int kb = it / nblk, nb = it % nblk;
        int n0 = 32 * nb, drow0 = n0;
        if (kind == 1) { const int up = n0 >= DFF, j0 = n0 - up * DFF; drow0 = (j0 >> 7) * 256 + (j0 & 127) + up * 128; }
        else if (kind == 2) { if (nb >= 96) n0 += 4; }
        tr_item(W, N, 64 * kb, n0, WT, ldt, drow0, dk0, scr, lane, gk);
    }
}

struct Args { const float* in[16]; float* out; unsigned char* ws; int ph_lo, ph_hi; };
constexpr int PTAB_OFF = 147456 - 256;
#define GAS_ __attribute__((address_space(1)))
#define PTR_(i) ((const float*)(GAS_ const float*)ld_ptr(lds, (i)))
__device__ __forceinline__ unsigned long long ld_ptr(LAS unsigned char* lds, int i) {
    const unsigned long long v = *((volatile LAS unsigned long long*)(lds + PTAB_OFF) + i);
    const unsigned lo = __builtin_amdgcn_readfirstlane((unsigned)v), hi = __builtin_amdgcn_readfirstlane((unsigned)(v >> 32));
    return ((unsigned long long)hi << 32) | lo;
}

__device__ __forceinline__ void conv_ffn(LAS unsigned char* lds, unsigned char* ws, int layer, int which  , int slot, LAS float* scr, int gw, int NGW, int lane, int parts = 3  , int off = 0) {
    const float* win = PTR_(which ? 13 : 2) + (size_t)layer * DM * 2 * DFF;
    const float* wout = PTR_(which ? 14 : 3) + (size_t)layer * DFF * DM;
    bf16* s = (bf16*)(ws + WS_T + (size_t)slot * FFN_SLOT);
    if (parts & 1) { conv_matrix(win, DM, 2 * DFF, 2 * DFF / 32, 1, s, DM, 0, scr, gw, NGW, lane, PTR_(which ? 12 : 1) + layer * DM, off); off += 2816; }
    if (parts & 2) conv_matrix(wout, DFF, DM, DM / 32, 0, (bf16*)((unsigned char*)s + FFN_SLOT_OUT), DFF, 0, scr, gw, NGW, lane, nullptr, off);
}
__device__ __forceinline__ void conv_mix(LAS unsigned char* lds, unsigned char* ws, int layer, LAS float* scr, int gw, int NGW, int lane, int off = 0) {
    unsigned char* wb = ws + WS_WMIX + (size_t)layer * WMIX_LAYER;
    conv_matrix(PTR_(5) + (size_t)layer * DM * INW, DM, INW, 192, 2, (bf16*)wb, DM, 0, scr, gw, NGW, lane, PTR_(4) + layer * DM, off);
    conv_matrix(PTR_(8) + (size_t)layer * 256 * DM, 256, DM, 32, 0, (bf16*)(wb + WMIX_BR), DM, 0, scr, gw, NGW, lane, nullptr, off + 3072);
    conv_matrix(PTR_(9) + (size_t)layer * 512 * DM, 512, DM, 32, 0, (bf16*)(wb + WMIX_BR), DM, 256, scr, gw, NGW, lane, nullptr, off + 3200);
    conv_matrix(PTR_(10) + (size_t)layer * 256 * DM, 256, DM, 32, 0, (bf16*)(wb + WMIX_BR), DM, 768, scr, gw, NGW, lane, nullptr, off + 3456);
    conv_matrix(PTR_(11) + (size_t)layer * DM * DM, DM, DM, 32, 0, (bf16*)(wb + WMIX_OUT), DM, 0, scr, gw, NGW, lane, nullptr, off + 3584);
}

template <int MODE>
__device__ __forceinline__ void norm_rows(const float* x, const float* g, bf16* xn, float* fout, const float* wf  , const float* bf_, float* fl, int gw, int NGW, int lane) {
    f32x4 gv[4];
#pragma unroll
    for (int j = 0; j < 4; ++j) gv[j] = *((const f32x4*)g + 64 * j + lane);
    f32x4 wv[4][4];
    if (MODE == 1) {
#pragma unroll
        for (int j = 0; j < 4; ++j)
#pragma unroll
            for (int e = 0; e < 4; ++e) { const int k = 256 * j + 4 * lane + e; const f32x4 w4 = *(const f32x4*)(wf + (size_t)k * INW + QW);
                wv[0][j][e] = w4[0]; wv[1][j][e] = w4[1]; wv[2][j][e] = w4[2]; wv[3][j][e] = w4[3]; }
    }
    for (int m = gw; m < M; m += NGW) {
        const f32x4* xr = (const f32x4*)(x + (size_t)m * DM) + lane;
        f32x4 v[4]; float s = 0.f;
#pragma unroll
        for (int j = 0; j < 4; ++j) { v[j] = xr[64 * j]; s += (v[j][0] * v[j][0] + v[j][1] * v[j][1]) + (v[j][2] * v[j][2] + v[j][3] * v[j][3]); }
        const float rstd = 1.0f / sqrtf(wave_sum(s, lane) * (1.0f / DM) + RMS_EPS);
#pragma unroll
        for (int j = 0; j < 4; ++j) v[j] = v[j] * rstd * gv[j];
        if (MODE == 2) {
            f32x4* o = (f32x4*)(fout + (size_t)m * DM) + lane;
#pragma unroll
            for (int j = 0; j < 4; ++j) o[64 * j] = v[j];
        } else {
            v2u* o8 = (v2u*)(xn + (size_t)m * DM) + lane;
#pragma unroll
            for (int j = 0; j < 4; ++j) { v2u w; w.x = pk2(v[j][0], v[j][1]); w.y = pk2(v[j][2], v[j][3]); o8[64 * j] = w; }
        }
        if (MODE == 1) {
            float d[4];
#pragma unroll
            for (int h = 0; h < 4; ++h) { float t = 0.f;
#pragma unroll
                for (int j = 0; j < 4; ++j) t += (v[j][0] * wv[h][j][0] + v[j][1] * wv[h][j][1]) + (v[j][2] * wv[h][j][2] + v[j][3] * wv[h][j][3]);
                d[h] = wave_sum(t, lane); }
            if (lane < 4) { const float z = (lane == 0 ? d[0] : lane == 1 ? d[1] : lane == 2 ? d[2] : d[3]) + bf_[lane];
                const float lf = fminf(z, 0.f) - log1pf(expf(-fabsf(z)));
                const int b = m / SEQ, t = m % SEQ; fl[(size_t)(b * 4 + lane) * SEQ + t] = lf; }
        }
    }
}

__device__ __forceinline__ void rows_raw(const float* x, bf16* xb, float* part, int gw, int NGW, int lane) {
    for (int m = gw; m < M; m += NGW) {
        const f32x4* xr = (const f32x4*)(x + (size_t)m * DM) + lane;
        f32x4 v[4]; float s = 0.f;
#pragma unroll
        for (int j = 0; j < 4; ++j) { v[j] = __builtin_nontemporal_load(xr + 64 * j); s += (v[j][0] * v[j][0] + v[j][1] * v[j][1]) + (v[j][2] * v[j][2] + v[j][3] * v[j][3]); }
        s = wave_sum(s, lane);
        v2u* o8 = (v2u*)(xb + (size_t)m * DM) + lane;
#pragma unroll
        for (int j = 0; j < 4; ++j) { v2u w; w.x = pk2(v[j][0], v[j][1]); w.y = pk2(v[j][2], v[j][3]); o8[64 * j] = w; }
        if (lane < 4) part[(size_t)lane * M + m] = lane == 0 ? s : 0.f;
    }
}

__device__ __forceinline__ void cumsum_seq(const float* part, const float* partd, const float* bfg  , float* fc, int seq, LAS float* scr, int tid) {
    const int lane = tid & 63, wid = tid >> 6, b = seq >> 2, hh = seq & 3;
    const float bias = bfg[hh];
    float lf[4];
#pragma unroll
    for (int e = 0; e < 4; ++e) {
        const int m = b * SEQ + 4 * tid + e;
        const float rs = pg8::row_rstd(part, m);
        const float dot = (partd[((size_t)m) * 4 + hh] + partd[((size_t)M + m) * 4 + hh]) + (partd[((size_t)2 * M + m) * 4 + hh] + partd[((size_t)3 * M + m) * 4 + hh]);
        const float z = rs * dot + bias;
        lf[e] = fminf(z, 0.f) - log1pf(expf(-fabsf(z)));
    }
    const float s1 = lf[0], s2 = s1 + lf[1], s3 = s2 + lf[2], s4 = s3 + lf[3];
    float inc = s4;
#pragma unroll
    for (int o = 1; o < 64; o <<= 1) { const float t = __int_as_float(__builtin_amdgcn_ds_bpermute(((lane - o) & 63) << 2, __float_as_int(inc))); if (lane >= o) inc += t; }
    if (lane == 63) scr[wid] = inc;
    __syncthreads();
    float base = 0.f;
    for (int w = 0; w < wid; ++w) base += scr[w];
    const float ex = base + inc - s4;
    f32x4 o; o[0] = ex + s1; o[1] = ex + s2; o[2] = ex + s3; o[3] = ex + s4;
    *((f32x4*)(fc + (size_t)seq * SEQ) + tid) = o * (-LOG2E);
    __syncthreads();
}

#define DOT64(z, q, kp) do { z = 0.f; _Pragma("unroll") for (int c_ = 0; c_ < 8; ++c_) { const v4u w_ = *((const v4u*)(kp) + c_); const v4u q_ = q[c_]; \
    z += pg8::bf_lo(q_[0]) * pg8::bf_lo(w_[0]) + pg8::bf_hi(q_[0]) * pg8::bf_hi(w_[0]) + pg8::bf_lo(q_[1]) * pg8::bf_lo(w_[1]) + pg8::bf_hi(q_[1]) * pg8::bf_hi(w_[1]) \
       + pg8::bf_lo(q_[2]) * pg8::bf_lo(w_[2]) + pg8::bf_hi(q_[2]) * pg8::bf_hi(w_[2]) + pg8::bf_lo(q_[3]) * pg8::bf_lo(w_[3]) + pg8::bf_hi(q_[3]) * pg8::bf_hi(w_[3]); } } while (0)
#define AXPY64(o, wt_, vp) do { _Pragma("unroll") for (int c_ = 0; c_ < 8; ++c_) { const v4u w_ = *((const v4u*)(vp) + c_); \
    o[c_ * 8 + 0] += (wt_) * pg8::bf_lo(w_[0]); o[c_ * 8 + 1] += (wt_) * pg8::bf_hi(w_[0]); o[c_ * 8 + 2] += (wt_) * pg8::bf_lo(w_[1]); o[c_ * 8 + 3] += (wt_) * pg8::bf_hi(w_[1]); \
    o[c_ * 8 + 4] += (wt_) * pg8::bf_lo(w_[2]); o[c_ * 8 + 5] += (wt_) * pg8::bf_hi(w_[2]); o[c_ * 8 + 6] += (wt_) * pg8::bf_lo(w_[3]); o[c_ * 8 + 7] += (wt_) * pg8::bf_hi(w_[3]); } } while (0)
#define LOADQ(q, qp) do { _Pragma("unroll") for (int c_ = 0; c_ < 8; ++c_) q[c_] = *((const v4u*)(qp) + c_); } while (0)
#define STOREO(op, o, sc) do { _Pragma("unroll") for (int c_ = 0; c_ < 8; ++c_) { v4u w_; w_.x = pk2(o[c_ * 8 + 0] * (sc), o[c_ * 8 + 1] * (sc)); w_.y = pk2(o[c_ * 8 + 2] * (sc), o[c_ * 8 + 3] * (sc)); \
    w_.z = pk2(o[c_ * 8 + 4] * (sc), o[c_ * 8 + 5] * (sc)); w_.w = pk2(o[c_ * 8 + 6] * (sc), o[c_ * 8 + 7] * (sc)); *((v4u*)(op) + c_) = w_; } } while (0)

__device__ __forceinline__ void attn_naive(const bf16* QKV, bf16* O, const float* fc, const float* rel  , int gw, int NGW, int lane, unsigned mask) {
    for (int wu = gw; wu < 4096; wu += NGW) {
        { const int mx_ = wu < 1024 ? 0 : (wu < 2048 ? 2 : 1); if (!((mask >> mx_) & 1u)) continue; }
        v4u q[8]; float o[64];
#pragma unroll
        for (int d = 0; d < 64; ++d) o[d] = 0.f;
        if (wu < 1024) {
            const int blk = 31 - (wu >> 5), bh = wu & 31, b = bh >> 2, h = bh & 3;
            const int t = blk * 64 + lane; const size_t row = (size_t)b * SEQ + t;
            const bf16* kb = QKV + (size_t)b * SEQ * QW + 256 + h * 64; const bf16* vb = kb + 256;
            LOADQ(q, QKV + row * QW + h * 64);
            float R = 0.f;
            for (int s = blk * 64 + 62; s >= 0; --s) {
                float z; DOT64(z, q, kb + (size_t)s * QW);
                const bool act = s < t;
                const float sp = fmaxf(z, 0.f) + log1pf(expf(-fabsf(z)));
                const float w = act ? expf(z - sp + R) : 0.f;
                R -= act ? sp : 0.f;
                AXPY64(o, w, vb + (size_t)s * QW);
            }
            STOREO(O + row * DM + h * 64, o, 1.0f);
        } else if (wu < 2048) {
            const int u = wu - 1024; const int blk = 31 - (u >> 5), bh = u & 31, b = bh >> 2, h = bh & 3;
            const int t = blk * 64 + lane; const size_t row = (size_t)b * SEQ + t;
            const bf16* kb = QKV + (size_t)b * SEQ * QW + 2560 + h * 64; const bf16* vb = kb + 256;
            const float* F = fc + (size_t)bh * SEQ;
            LOADQ(q, QKV + row * QW + 2304 + h * 64);
            float mx = -1e30f, l = 0.f;
            for (int s = 0; s <= blk * 64 + 63; ++s) {
                float z; DOT64(z, q, kb + (size_t)s * QW);
                z -= F[s];
                const bool act = s <= t;
                const float mn = act ? fmaxf(mx, z) : mx;
                const float al = expf(mx - mn), p = act ? expf(z - mn) : 0.f;
                mx = mn; l = l * al + p;
#pragma unroll
                for (int d = 0; d < 64; ++d) o[d] *= al;
                AXPY64(o, p, vb + (size_t)s * QW);
            }
            const float il = 1.0f / l;
            STOREO(O + row * DM + 768 + h * 64, o, il);
        } else {
            const int u = wu - 2048; const int c = u >> 6, bh = u & 63, b = bh >> 3, h = bh & 7;
            const int t = c * 64 + lane; const size_t row = (size_t)b * SEQ + t;
            const bf16* kb = QKV + (size_t)b * SEQ * QW + 1280 + h * 64; const bf16* vb = kb + 512;
            LOADQ(q, QKV + row * QW + 768 + h * 64);
            float mx = -1e30f, l = 0.f;
            const int s_lo = c >= 8 ? (c - 8) * 64 : 0;
            for (int s = s_lo; s <= c * 64 + 63; ++s) {
                float z; DOT64(z, q, kb + (size_t)s * QW);
                int rl = t - s; rl = rl > 128 ? 128 : (rl < -128 ? -128 : rl);
                z += rel[(rl + 128) * 8 + h];
                const float mn = fmaxf(mx, z);
                const float al = expf(mx - mn), p = expf(z - mn);
                mx = mn; l = l * al + p;
#pragma unroll
                for (int d = 0; d < 64; ++d) o[d] *= al;
                AXPY64(o, p, vb + (size_t)s * QW);
            }
            const float il = 1.0f / l;
            STOREO(O + row * DM + 256 + h * 64, o, il);
        }
    }
}

namespace att {
typedef short bf16x8 __attribute__((ext_vector_type(8)));
typedef short s16x4 __attribute__((ext_vector_type(4)));
typedef float f32x16 __attribute__((ext_vector_type(16)));
constexpr int WLDS = 17664;
__device__ __forceinline__ int crow(int r, int h) { return (r & 3) + 8 * (r >> 2) + 4 * h; }
__device__ __forceinline__ float xchg32(float v, int lane) { return __int_as_float(__builtin_amdgcn_ds_bpermute((lane ^ 32) << 2, __float_as_int(v))); }
__device__ __forceinline__ float ex2(float v) { return __builtin_amdgcn_exp2f(v); }
__device__ __forceinline__ float lg2(float v) { return __builtin_amdgcn_logf(v); }

__device__ __forceinline__ void load_k(bf16x8 (&k)[2][4], const bf16* kb) {
#pragma unroll
    for (int hf = 0; hf < 2; ++hf)
#pragma unroll
        for (int d0 = 0; d0 < 4; ++d0) k[hf][d0] = *(const bf16x8*)(kb + (size_t)(32 * hf) * QW + 16 * d0);
}
__device__ __forceinline__ void glds16(const void* gsrc, unsigned lds_dst) {
    unsigned keep;
    asm volatile("s_mov_b32 %0, m0\n\ts_mov_b32 m0, %2\n\ts_nop 0\n\tglobal_load_lds_dwordx4 %1, off\n\ts_mov_b32 m0, %0" : "=&s"(keep) : "v"(gsrc), "s"(lds_dst) : "memory");
}
__device__ __forceinline__ void dma_v(LAS unsigned char* vimg, const bf16* vb) {
    const unsigned dst = (unsigned)__builtin_amdgcn_readfirstlane((int)(unsigned)(uintptr_t)vimg);
#pragma unroll
    for (int i = 0; i < 8; ++i) glds16(vb + (size_t)(16 * (i >> 1)) * QW + 32 * (i & 1), dst + (unsigned)((i & 1) * 4096 + (i >> 1) * 1024));
}
__device__ __forceinline__ void wait_v() { asm volatile("s_waitcnt vmcnt(0)" ::: "memory"); }
__device__ __forceinline__ void qk(f32x16 (&S)[2], const bf16x8 (&k)[2][4], const bf16x8 (&q)[4]) {
    __builtin_amdgcn_s_setprio(1);
#pragma unroll
    for (int hf = 0; hf < 2; ++hf) {
        f32x16 acc = S[hf];
#pragma unroll
        for (int d0 = 0; d0 < 4; ++d0) acc = __builtin_amdgcn_mfma_f32_32x32x16_bf16(k[hf][d0], q[d0], acc, 0, 0, 0);
        S[hf] = acc;
    }
    __builtin_amdgcn_s_setprio(0);
}
__device__ __forceinline__ s16x4 vtr(LAS unsigned char* p) {
    typedef short v4i16_t __attribute__((ext_vector_type(4)));
    return __builtin_bit_cast(s16x4, __builtin_amdgcn_ds_read_tr16_b64_v4i16((LAS v4i16_t*)p));
}
__device__ __forceinline__ void pv(f32x16 (&o)[2], LAS unsigned char* vimg, int lane, const f32x16 (&S)[2]) {
    const int h = lane >> 5;
    LAS unsigned char* vb = vimg + (4 * h + ((lane & 15) >> 2)) * 64 + ((lane >> 4) & 1) * 32 + (lane & 3) * 8;
#pragma unroll
    for (int hf = 0; hf < 2; ++hf)
#pragma unroll
        for (int s = 0; s < 2; ++s) {
            v4u pw; pw[0] = pg8::pk_bf16(S[hf][8 * s + 0], S[hf][8 * s + 1]); pw[1] = pg8::pk_bf16(S[hf][8 * s + 2], S[hf][8 * s + 3]);
            pw[2] = pg8::pk_bf16(S[hf][8 * s + 4], S[hf][8 * s + 5]); pw[3] = pg8::pk_bf16(S[hf][8 * s + 6], S[hf][8 * s + 7]);
            const bf16x8 pf = __builtin_bit_cast(bf16x8, pw);
#pragma unroll
            for (int db = 0; db < 2; ++db) {
                LAS unsigned char* p = vb + db * 4096 + (32 * hf + 16 * s) * 64;
                const s16x4 lo = vtr(p), hi = vtr(p + 512);
                const bf16x8 vf = (bf16x8){lo[0], lo[1], lo[2], lo[3], hi[0], hi[1], hi[2], hi[3]};
                o[db] = __builtin_amdgcn_mfma_f32_32x32x16_bf16(vf, pf, o[db], 0, 0, 0);
            }
        }
    asm volatile("" ::: "memory");
}
__device__ __forceinline__ void store_o(bf16* orow  , const f32x16 (&o)[2], float sc, int h) {
#pragma unroll
    for (int db = 0; db < 2; ++db)
#pragma unroll
        for (int g = 0; g < 4; ++g) {
            v2u w; w.x = pg8::pk_bf16(o[db][4 * g] * sc, o[db][4 * g + 1] * sc); w.y = pg8::pk_bf16(o[db][4 * g + 2] * sc, o[db][4 * g + 3] * sc);
            *(v2u*)(orow + 32 * db + 8 * g + 4 * h) = w;
        }
}
template <bool DIAG>
__device__ __forceinline__ void sb_tile(f32x16 (&S)[2], float& R, int kv0, int t, int h, int lane) {
    const int dd = t - kv0 - 4 * h;
    float lf[2][16];
#pragma unroll
    for (int hf = 0; hf < 2; ++hf)
#pragma unroll
        for (int r = 0; r < 16; ++r) {
            const float z = S[hf][r];
            const float sp = fmaxf(z, 0.f) + LN2 * lg2(1.0f + ex2(-LOG2E * fabsf(z)));
            const bool valid = !DIAG || ((32 * hf + (r & 3) + 8 * (r >> 2)) < dd);
            lf[hf][r] = valid ? -sp : 0.f;
        }
    float pg[8], tot[8];
#pragma unroll
    for (int pi = 0; pi < 8; ++pi) { const int hf = pi >> 2, g = pi & 3;
        const float gs = (lf[hf][4 * g] + lf[hf][4 * g + 1]) + (lf[hf][4 * g + 2] + lf[hf][4 * g + 3]);
        pg[pi] = xchg32(gs, lane); tot[pi] = gs + pg[pi]; }
    float suf = R;
#pragma unroll
    for (int pi = 7; pi >= 0; --pi) { const int hf = pi >> 2, g = pi & 3;
        float a = suf + (h == 0 ? pg[pi] : 0.f);
        suf += tot[pi];
#pragma unroll
        for (int e = 3; e >= 0; --e) { const int r = 4 * g + e;
            a += lf[hf][r];
            const bool valid = !DIAG || ((32 * hf + (r & 3) + 8 * (r >> 2)) < dd);
            S[hf][r] = valid ? ex2(LOG2E * (S[hf][r] + a)) : 0.f; }
    }
    R = suf;
}
__device__ __forceinline__ void osm_tile(f32x16 (&S)[2], f32x16 (&o)[2], float& m_run, float& l_run, int lane) {
    float mq[4] = {S[0][0], S[0][1], S[0][2], S[0][3]};
#pragma unroll
    for (int hf = 0; hf < 2; ++hf)
#pragma unroll
        for (int r = 0; r < 16; ++r) mq[r & 3] = fmaxf(mq[r & 3], S[hf][r]);
    float mx = fmaxf(fmaxf(mq[0], mq[1]), fmaxf(mq[2], mq[3]));
    mx = fmaxf(mx, xchg32(mx, lane));
    const float mn = fmaxf(m_run, mx), al = ex2(m_run - mn);
    float sq[4] = {0.f, 0.f, 0.f, 0.f};
#pragma unroll
    for (int hf = 0; hf < 2; ++hf)
#pragma unroll
        for (int r = 0; r < 16; ++r) { const float p = ex2(S[hf][r] - mn); S[hf][r] = p; sq[r & 3] += p; }
    const float sum = (sq[0] + sq[1]) + (sq[2] + sq[3]);
    l_run = l_run * al + sum;
    if (__any(mn > m_run)) {
#pragma unroll
        for (int db = 0; db < 2; ++db)
#pragma unroll
            for (int r = 0; r < 16; ++r) o[db][r] *= al;
    }
    m_run = mn;
}

#ifndef SB_EARLY_EXIT
#define SB_EARLY_EXIT 1
#endif
constexpr float SB_CUT = -110.0f;

template <int MX>
__device__ __forceinline__ void unit_body(const bf16* qp, const bf16* kb, const bf16* vb, bf16* orow, LAS unsigned char* vimg, LAS const float* tab, const float* F,
                                          int ntile, int kv_first, int step, int t, int cdist0  , int lane,
                                          unsigned* ctr, unsigned ngw, unsigned& nidx) {
    const int trig = (MX == 0) ? (ntile > 1 ? 1 : 0) : ntile - 1; bool got = false;
    const int h = lane >> 5;
    f32x16 o[2]; o[0] = f32x16{}; o[1] = f32x16{};
    bf16x8 qf[4], kf[2][4], kn[2][4]; f32x16 S[2];
#pragma unroll
    for (int d0 = 0; d0 < 4; ++d0) qf[d0] = *(const bf16x8*)(qp + 16 * d0);
    dma_v(vimg, vb + (size_t)kv_first * QW);
    load_k(kf, kb + (size_t)kv_first * QW);
    float R = 0.f, m_run = -1e30f, l_run = 0.f;
    f32x4 fk[2][4], fkn[2][4];
    if (MX == 2) {
#pragma unroll
        for (int hf = 0; hf < 2; ++hf)
#pragma unroll
            for (int g = 0; g < 4; ++g) fk[hf][g] = *(const f32x4*)(F + kv_first + 32 * hf + 8 * g + 4 * h);
    }
    for (int j = 0; j < ntile; ++j) {
        if (j == trig) { if (lane == 0) nidx = ngw + atomicAdd(ctr, 1u); got = true; }
        const int kv0 = kv_first + j * step; const bool has_next = j + 1 < ntile;
        LAS unsigned char* vcur = vimg + (j & 1) * 8192; LAS unsigned char* vnext = vimg + ((j & 1) ^ 1) * 8192;
        asm volatile("s_waitcnt lgkmcnt(0)" ::: "memory");
        const int kvn = has_next ? kv0 + step : kv0;
        if (MX == 2) {
#pragma unroll
            for (int hf = 0; hf < 2; ++hf)
#pragma unroll
                for (int r = 0; r < 16; ++r) S[hf][r] = fk[hf][r >> 2][r & 3];
        } else if (MX == 1) {
            if (cdist0 - j >= 3) { const float bc = tab[256];
#pragma unroll
                for (int hf = 0; hf < 2; ++hf)
#pragma unroll
                    for (int r = 0; r < 16; ++r) S[hf][r] = bc;
            } else { const int relb = t - kv0 + 128 - 4 * h;
#pragma unroll
                for (int hf = 0; hf < 2; ++hf)
#pragma unroll
                    for (int r = 0; r < 16; ++r) { int ix = relb - (32 * hf + (r & 3) + 8 * (r >> 2)); ix = ix > 256 ? 256 : ix; S[hf][r] = tab[ix]; }
            }
        } else { S[0] = f32x16{}; S[1] = f32x16{}; }
        qk(S, kf, qf);
        __builtin_amdgcn_sched_barrier(0);
        dma_v(vnext, vb + (size_t)kvn * QW);
        load_k(kn, kb + (size_t)kvn * QW);
        if (MX == 2) {
#pragma unroll
            for (int hf = 0; hf < 2; ++hf)
#pragma unroll
                for (int g = 0; g < 4; ++g) fkn[hf][g] = *(const f32x4*)(F + kvn + 32 * hf + 8 * g + 4 * h);
        }
        __builtin_amdgcn_sched_barrier(0);
        if (MX == 0) {
            if (j == 0) sb_tile<true>(S, R, kv0, t, h, lane); else sb_tile<false>(S, R, kv0, t, h, lane);
        } else if (MX == 2) {
            if (!has_next) {
                const int dd = t - kv0 - 4 * h;
#pragma unroll
                for (int hf = 0; hf < 2; ++hf)
#pragma unroll
                    for (int r = 0; r < 16; ++r) if ((32 * hf + (r & 3) + 8 * (r >> 2)) > dd) S[hf][r] = -1e30f;
            }
            osm_tile(S, o, m_run, l_run, lane);
        } else {
            osm_tile(S, o, m_run, l_run, lane);
        }
        if (MX == 2) asm volatile("s_waitcnt vmcnt(24)" ::: "memory"); else asm volatile("s_waitcnt vmcnt(16)" ::: "memory");
        pv(o, vcur, lane, S);
#if SB_EARLY_EXIT
        if (MX == 0) { if (__all(R < SB_CUT)) break; }
#endif
#pragma unroll
        for (int hf = 0; hf < 2; ++hf)
#pragma unroll
            for (int d0 = 0; d0 < 4; ++d0) kf[hf][d0] = kn[hf][d0];
        if (MX == 2) {
#pragma unroll
            for (int hf = 0; hf < 2; ++hf)
#pragma unroll
                for (int g = 0; g < 4; ++g) fk[hf][g] = fkn[hf][g];
        }
    }
    if (!got) { if (lane == 0) nidx = ngw + atomicAdd(ctr, 1u); }
    asm volatile("s_waitcnt vmcnt(0) lgkmcnt(0)" ::: "memory");
    float sc = 1.0f;
    if (MX != 0) { l_run += xchg32(l_run, lane); sc = 1.0f / l_run; }
    store_o(orow, o, sc, h);
}

__device__ __forceinline__ void attn_mfma(const bf16* QKV, bf16* O, const float* fc, const float* rel, unsigned* ctr, LAS unsigned char* lds, int wave, int lane_in, unsigned mask, unsigned nunits) {
    const unsigned ngw = gridDim.x * NWAVES; bool first = true; unsigned nidx = 0;
    for (;;) {
        int lane = lane_in; asm volatile("" : "+v"(lane));
        LAS unsigned char* vimg = lds + wave * WLDS;
        LAS float* tab = (LAS float*)(vimg + 16384);
        const int r32 = lane & 31, h = lane >> 5;
        unsigned idx = 0;
        if (first) { idx = blockIdx.x * NWAVES + (unsigned)wave; first = false; }
        else idx = __builtin_amdgcn_readfirstlane(nidx);
        if (idx >= nunits) break;
        int mixer, u;
        if (idx < 1664u) { mixer = 2; u = (int)idx; }
        else if (idx < 3712u) { mixer = 0; u = (int)idx - 1664; }
        else if (idx < 4096u) { mixer = 2; u = (int)idx - 2048; }
        else { mixer = 1; u = 0; }
        if (!((mask >> mixer) & 1u)) continue;
        if (mixer != 1) {
            const int qb = 63 - (u >> 5), bh = u & 31, b = bh >> 2, hd = bh & 3;
            const int t0 = 32 * qb, t = t0 + r32, kt_hi = t0 >> 6;
            const int qoff = (mixer == 0 ? 0 : 2304) + 64 * hd, koff = qoff + 256, voff = koff + 256;
            const bf16* base = QKV + (size_t)b * SEQ * QW;
            const bf16* qp = base + (size_t)t * QW + qoff + 8 * h;
            const bf16* kb = base + (size_t)r32 * QW + koff + 8 * h;
            const bf16* vb = base + (size_t)(lane >> 2) * QW + voff + 8 * (lane & 3);
            bf16* orow = O + ((size_t)b * SEQ + t) * DM + (mixer == 0 ? 0 : 768) + 64 * hd;
            if (mixer == 0) unit_body<0>(qp, kb, vb, orow, vimg, tab, nullptr, kt_hi + 1, 64 * kt_hi, -64, t, 0, lane, ctr, ngw, nidx);
            else unit_body<2>(qp, kb, vb, orow, vimg, tab, fc + (size_t)bh * SEQ, kt_hi + 1, 0, 64, t, 0, lane, ctr, ngw, nidx);
        } else {
            const int u = (int)(idx - 4096u), bh = u & 63, rb = u >> 6, b = bh >> 3, hd = bh & 7;
            const int t0 = 32 * rb, t = t0 + r32, c = rb >> 1;
            const bf16* base = QKV + (size_t)b * SEQ * QW;
            const int qoff = 768 + 64 * hd, koff = 1280 + 64 * hd, voff = 1792 + 64 * hd;
            asm volatile("" ::: "memory");
#pragma unroll
            for (int i = 0; i < 5; ++i) { const int j = lane + 64 * i; if (j < NREL) tab[j] = LOG2E * rel[j * 8 + hd]; }
            asm volatile("s_waitcnt lgkmcnt(0)" ::: "memory");
            const bf16* qp = base + (size_t)t * QW + qoff + 8 * h;
            const bf16* kb = base + (size_t)r32 * QW + koff + 8 * h;
            const bf16* vb = base + (size_t)(lane >> 2) * QW + voff + 8 * (lane & 3);
            bf16* orow = O + ((size_t)b * SEQ + t) * DM + 256 + 64 * hd;
            const int kc_lo = c >= 8 ? c - 8 : 0;
            unit_body<1>(qp, kb, vb, orow, vimg, tab, nullptr, c - kc_lo + 1, 64 * kc_lo, 64, t, c - kc_lo, lane, ctr, ngw, nidx);
        }
    }
}

constexpr int CB_D = 3, CB_NBUF = CB_D + 1;
constexpr int CB_TAB = CB_NBUF * 16384, CB_WORD = CB_TAB + 8 * 1280;
__device__ __forceinline__ void attn_b_coop(const bf16* QKV, bf16* O, const float* rel, unsigned* ctr, LAS unsigned char* lds, int wave, int lane_in, int tid) {
    bool first = true; unsigned nxt_u = 0;
    for (;;) {
        int lane = lane_in; asm volatile("" : "+v"(lane));
        const int r32 = lane & 31, h = lane >> 5;
        if (tid == 0) { const unsigned uu = first ? blockIdx.x : nxt_u; *(volatile LAS unsigned*)(lds + CB_WORD) = uu; }
        first = false;
        asm volatile("s_waitcnt vmcnt(0) lgkmcnt(0)\n\ts_barrier" ::: "memory");
        const unsigned u = (unsigned)__builtin_amdgcn_readfirstlane((int)*(volatile LAS unsigned*)(lds + CB_WORD));
        if (u >= 512u) break;
        const int bh = (int)(u & 63u), grp = 7 - (int)(u >> 6), b = bh >> 3, hd = bh & 7;
        const int c0 = 4 * grp, c = c0 + (wave >> 1), rb = 2 * c + (wave & 1), t = 32 * rb + r32;
        const int kc_lo = c0 >= 8 ? c0 - 8 : 0, ntile = c0 + 3 - kc_lo + 1;
        const int my_lo = c >= 8 ? c - 8 : 0;
        const bf16* base = QKV + (size_t)b * SEQ * QW;
        const bf16* ksrc = base + (size_t)(64 * kc_lo + 32 * (wave >> 2) + r32) * QW + 1280 + 64 * hd + 16 * (wave & 3) + 8 * h;
        const bf16* vsrc = base + (size_t)(64 * kc_lo + 16 * (wave >> 1) + (lane >> 2)) * QW + 1792 + 64 * hd + 32 * (wave & 1) + 8 * (lane & 3);
        const unsigned lds0 = (unsigned)__builtin_amdgcn_readfirstlane((int)(unsigned)(uintptr_t)lds);
        const unsigned kdst = lds0 + (unsigned)wave * 1024u, vdst = lds0 + 8192u + (unsigned)((wave & 1) * 4096 + (wave >> 1) * 1024);
#define CB_ISSUE(jj) do { const int jc_ = (jj) < ntile ? (jj) : ntile - 1; const unsigned bo_ = (unsigned)((jj) % CB_NBUF) * 16384u; \
        glds16(ksrc + (size_t)(64 * jc_) * QW, kdst + bo_); glds16(vsrc + (size_t)(64 * jc_) * QW, vdst + bo_); } while (0)
#pragma unroll
        for (int jj = 0; jj < CB_D; ++jj) CB_ISSUE(jj);
        const bf16* qp = base + (size_t)t * QW + 768 + 64 * hd + 8 * h;
        bf16x8 qf[4];
#pragma unroll
        for (int d0 = 0; d0 < 4; ++d0) qf[d0] = *(const bf16x8*)(qp + 16 * d0);
        LAS float* tab = (LAS float*)(lds + CB_TAB + wave * 1280);
#pragma unroll
        for (int i = 0; i < 5; ++i) { const int j = lane + 64 * i; if (j < NREL) tab[j] = LOG2E * rel[j * 8 + hd]; }
        asm volatile("s_waitcnt vmcnt(0)" :: "v"(qf[0]), "v"(qf[1]), "v"(qf[2]), "v"(qf[3]) : "memory");
        f32x16 o[2]; o[0] = f32x16{}; o[1] = f32x16{};
        float m_run = -1e30f, l_run = 0.f;
        for (int j = 0; j < ntile; ++j) {
            const int kc = kc_lo + j, kv0 = 64 * kc;
            const unsigned bo = (unsigned)(j % CB_NBUF) * 16384u;
            asm volatile("s_waitcnt vmcnt(4) lgkmcnt(0)\n\ts_barrier" ::: "memory");
            CB_ISSUE(j + CB_D);
            if (j == ntile - 1 && tid == 0) nxt_u = gridDim.x + atomicAdd(ctr, 1u);
            if (kc >= my_lo && kc <= c) {
                LAS unsigned char* kimg = lds + bo; LAS unsigned char* vimg = lds + bo + 8192;
                bf16x8 kf[2][4]; f32x16 S[2];
#pragma unroll
                for (int hf = 0; hf < 2; ++hf)
#pragma unroll
                    for (int d0 = 0; d0 < 4; ++d0) kf[hf][d0] = *(const LAS bf16x8*)(kimg + (hf * 4 + d0) * 1024 + 16 * lane);
                if (c - kc >= 3) {
                    const float bc = tab[256];
#pragma unroll
                    for (int hf = 0; hf < 2; ++hf)
#pragma unroll
                        for (int r = 0; r < 16; ++r) S[hf][r] = bc;
                } else {
                    const int relb = t - kv0 + 128 - 4 * h;
#pragma unroll
                    for (int hf = 0; hf < 2; ++hf)
#pragma unroll
                        for (int r = 0; r < 16; ++r) { int ix = relb - (32 * hf + (r & 3) + 8 * (r >> 2)); ix = ix > 256 ? 256 : ix; S[hf][r] = tab[ix]; }
                }
                qk(S, kf, qf);
                osm_tile(S, o, m_run, l_run, lane);
                pv(o, vimg, lane, S);
            }
        }
#undef CB_ISSUE
        l_run += xchg32(l_run, lane);
        store_o(O + ((size_t)b * SEQ + t) * DM + 256 + 64 * hd, o, 1.0f / l_run, h);
    }
}
}

#define XB_TMO      128
#define XB_XCNT(j)  (256  + 64 * (j))
#define XB_XSUB(j)  (1280 + 64 * (j))
#define XB_XGEN(j)  (2304 + 64 * (j))
#define XB_TOP      3328
#define XB_TOPGEN   3392
#define XCD_BAR_WORDS 3456
#define XB_SPIN_CAP (1u << 18)
__device__ __forceinline__ unsigned xb_ld(unsigned* p)              { return __hip_atomic_load(p, __ATOMIC_RELAXED, __HIP_MEMORY_SCOPE_AGENT); }
__device__ __forceinline__ unsigned xb_add(unsigned* p, unsigned v) { return __hip_atomic_fetch_add(p, v, __ATOMIC_RELAXED, __HIP_MEMORY_SCOPE_AGENT); }
__device__ __forceinline__ unsigned xb_xcc_id() { return (unsigned)__builtin_amdgcn_s_getreg((3 << 11) | 20) & 0xFu; }
#define XB_SPIN(cond, bar) do { unsigned _sp = 0; while (cond) { __builtin_amdgcn_s_sleep(1); \
    if ((++_sp & 255u) == 0u) { if (xb_ld(&(bar)[XB_TMO])) break; if (_sp > XB_SPIN_CAP) { atomicAdd(&(bar)[XB_TMO], 1u); break; } } } } while (0)
struct XcdBarrier { unsigned* bar; unsigned x; volatile LAS unsigned* st; };
__device__ __forceinline__ XcdBarrier xcd_barrier_post(unsigned* bar, volatile LAS unsigned* st) {
    XcdBarrier b; b.bar = bar; b.x = xb_xcc_id(); b.st = st;
    if (threadIdx.x == 0) (void)xb_add(&bar[XB_XCNT(b.x)], 1u);
    return b;
}
__device__ __forceinline__ void xcd_barrier_complete(unsigned* bar, unsigned x, unsigned& nloc, unsigned& nx) {
    const unsigned G = gridDim.x * gridDim.y * gridDim.z;
    unsigned sum, cnt, mine, sp = 0u;
    for (;;) {
        sum = 0u; cnt = 0u; mine = 0u;
#pragma unroll
        for (unsigned j = 0; j < 16; ++j) { const unsigned c = xb_ld(&bar[XB_XCNT(j)]); sum += c; cnt += (c > 0u) ? 1u : 0u; mine = (j == x) ? c : mine; }
        if (sum == G) break;
        __builtin_amdgcn_s_sleep(1);
        if ((++sp & 255u) == 0u) { if (xb_ld(&bar[XB_TMO])) break; if (sp > XB_SPIN_CAP) { atomicAdd(&bar[XB_TMO], 1u); break; } }
    }
    nloc = mine > 0u ? mine : 1u; nx = cnt > 0u ? cnt : 1u;
}
__device__ __forceinline__ void xcd_barrier(const XcdBarrier& b) {
    asm volatile("s_waitcnt vmcnt(0)" ::: "memory");
    __syncthreads();
    if (threadIdx.x == 0) {
        unsigned* bar = b.bar;
        __builtin_amdgcn_s_waitcnt(0);
        unsigned nloc = b.st[0], nx = b.st[1];
        if (nloc == 0u) { xcd_barrier_complete(bar, b.x, nloc, nx); b.st[0] = nloc; b.st[1] = nx; }
        const unsigned old = xb_add(&bar[XB_XSUB(b.x)], 1u);
        const unsigned gen = old / nloc;
        if (old + 1u == (gen + 1u) * nloc) {
            __builtin_amdgcn_fence(__ATOMIC_RELEASE, "agent");
            asm volatile("s_waitcnt vmcnt(0)" ::: "memory");
            const unsigned og = xb_add(&bar[XB_TOP], 1u);
            const unsigned tg = og / nx;
            if (og + 1u == (tg + 1u) * nx) xb_add(&bar[XB_TOPGEN], 1u);
            else XB_SPIN(xb_ld(&bar[XB_TOPGEN]) == tg, bar);
            __builtin_amdgcn_fence(__ATOMIC_ACQUIRE, "agent");
            xb_add(&bar[XB_XGEN(b.x)], 1u);
            asm volatile("s_waitcnt vmcnt(0)" ::: "memory");
        } else {
            XB_SPIN(xb_ld(&bar[XB_XGEN(b.x)]) == gen, bar);
            __builtin_amdgcn_fence(__ATOMIC_ACQUIRE, "agent");
            asm volatile("s_waitcnt vmcnt(0)" ::: "memory");
        }
    }
    __syncthreads();
}

constexpr int N_PHASES = 17;

__global__ void __launch_bounds__(NWAVES * 64, 2) mk_fwd(Args a) {
    extern __shared__ __attribute__((aligned(16))) unsigned char lds_raw[];
    LAS unsigned char* lds = (LAS unsigned char*)lds_raw;
    const int G = gridDim.x, bx = blockIdx.x, NGW = G * NWAVES;
    { LAS unsigned long long* tab = (LAS unsigned long long*)(lds + PTAB_OFF); const int t0 = threadIdx.x;
      if (t0 < 16) tab[t0] = (unsigned long long)a.in[t0];
      if (t0 == 16) tab[16] = (unsigned long long)a.out;
      if (t0 == 17) tab[17] = (unsigned long long)a.ws;
      if (t0 == 18) { ((LAS unsigned*)(lds + PTAB_OFF + 192))[0] = 0u; ((LAS unsigned*)(lds + PTAB_OFF + 192))[1] = 0u; } }
    __syncthreads();
    const XcdBarrier xbar = xcd_barrier_post((unsigned*)(a.ws + WS_CTL) + CW_BAR, (volatile LAS unsigned*)(lds + PTAB_OFF + 192));
    if (a.ph_lo < 0) cg::this_grid().sync();
    const int ph_lo = a.ph_lo, ph_hi = a.ph_hi;
#define PTR(i) ((const float*)(GAS_ const float*)ld_ptr(lds, (i)))
#define PH_BEGIN \
        int tid_ = threadIdx.x; asm volatile("" : "+v"(tid_)); \
        const int tid = tid_, lane = tid & 63, wave = __builtin_amdgcn_readfirstlane(tid >> 6); \
        const int gw = bx * NWAVES + wave; (void)gw; (void)lane; \
        LAS float* scr = (LAS float*)(lds + wave * 16384); (void)scr; \
        unsigned char* ws = (unsigned char*)(GAS_ unsigned char*)ld_ptr(lds, 17); \
        float* X = (float*)(GAS_ float*)ld_ptr(lds, 16); (void)X; \
        bf16* XN = (bf16*)(ws + WS_XN); bf16* QKV = (bf16*)(ws + WS_R1); bf16* GT = (bf16*)(ws + WS_R2); bf16* HB = (bf16*)(ws + WS_R2); \
        bf16* MG = (bf16*)(ws + WS_MERGED); float* TB = (float*)(ws + WS_T); float* PART = (float*)(ws + WS_PART); float* PARTD = (float*)(ws + WS_PARTD); float* FC = (float*)(ws + WS_FC); \
        (void)XN; (void)QKV; (void)GT; (void)HB; (void)MG; (void)TB; (void)PART; (void)PARTD; (void)FC;
#define IN(k) (ph_lo <= (k) && (k) < ph_hi)
#define SEAM(k) do { if (IN(k) && IN((k) + 1)) xcd_barrier(xbar); } while (0)

    if (IN(0)) { PH_BEGIN
        conv_ffn(lds, ws, 0, 0, 0, scr, gw, NGW, lane, 1);
        rows_raw(PTR(0), XN, PART, gw, NGW, lane);
    }
    SEAM(0);
#define LAYER(L, P0) \
    if (IN(P0)) { PH_BEGIN const bf16* w = (const bf16*)(ws + WS_T + (size_t)(L == 0 ? 0 : 2) * FFN_SLOT); \
        pg8::Gemm g{XN, w}; pg8::StaticOrder S; S.init(M, 2 * DFF, G, bx); pg8::EpiSwiglu E{HB, DFF, PART}; \
        for (int rep = 0; rep <= PROBE_G1; ++rep) pg8::gemm_phase<pg8::EpiSwiglu, pg8::StaticOrder, DM, DM, DM>(lds, g, S, E); \
        {     \
            const int nidle = G - (1408 % G); \
            if (1408 % G != 0 && bx >= 1408 % G) { if (L == 0) conv_ffn(lds, ws, 0, 0, 0, scr, (bx - 1408 % G) * NWAVES + wave, nidle * NWAVES, lane, 2); \
                                                    conv_mix(lds, ws, L, scr, (bx - 1408 % G) * NWAVES + wave, nidle * NWAVES, lane, L == 0 ? 1408 : 0); } \
            else if (1408 % G == 0) { if (L == 0) conv_ffn(lds, ws, 0, 0, 0, scr, gw, NGW, lane, 2); conv_mix(lds, ws, L, scr, gw, NGW, lane, L == 0 ? 1408 : 0); } } } \
    SEAM(P0); \
    if (IN(P0 + 1)) { PH_BEGIN const bf16* w = (const bf16*)(ws + WS_T + (size_t)(L == 0 ? 0 : 2) * FFN_SLOT + FFN_SLOT_OUT); \
        pg8::Gemm g{HB, w}; pg8::StaticOrder S; S.init(M, DM, G, bx); \
        pg8::EpiResid E{XN, X, XN, PART, PARTD, PTR(5) + (size_t)L * DM * INW, PTR(4) + L * DM, nullptr, nullptr, 0.5f}; \
        pg8::gemm_phase<pg8::EpiResid, pg8::StaticOrder, DFF, DFF, DFF>(lds, g, S, E); } \
    SEAM(P0 + 1); \
    if (IN(P0 + 2)) { PH_BEGIN if (bx < 32) cumsum_seq(PART, PARTD, PTR(6) + L * INW + QW, FC, bx, (LAS float*)lds, tid); \
        const bf16* w = (const bf16*)(ws + WS_WMIX + (size_t)L * WMIX_LAYER); \
        pg8::Gemm g{XN, w}; pg8::StaticOrder S; S.init(M, 2 * QW, G, bx); pg8::EpiQKVG E{QKV, GT, PTR(6) + L * INW, PART}; \
        pg8::gemm_phase<pg8::EpiQKVG, pg8::StaticOrder, DM, DM, DM>(lds, g, S, E); } \
    SEAM(P0 + 2); \
    if (IN(P0 + 3)) { PH_BEGIN \
        att::attn_b_coop(QKV, (bf16*)X, PTR(7) + L * NREL * 8, (unsigned*)(ws + WS_CTL) + 4 + L, lds, wave, lane, tid); \
        if (PROBE_ATT == 1) att::attn_b_coop(QKV, (bf16*)X, PTR(7) + L * NREL * 8, (unsigned*)(ws + WS_CTL) + 6 + L, lds, wave, lane, tid); \
        att::attn_mfma(QKV, (bf16*)X, FC, PTR(7) + L * NREL * 8, (unsigned*)(ws + WS_CTL) + L, lds, wave, lane, 5u, 4096u); \
        if (PROBE_ATT == 2) att::attn_mfma(QKV, (bf16*)X, FC, PTR(7) + L * NREL * 8, (unsigned*)(ws + WS_CTL) + 2 + L, lds, wave, lane, 5u, 4096u); \
        if (PROBE_ATT == 3) att::attn_mfma(QKV, (bf16*)X, FC, PTR(7) + L * NREL * 8, (unsigned*)(ws + WS_CTL) + 2 + L, lds, wave, lane, 1u, 2048u); \
        if (7u & ~MFMA_MASK) attn_naive(QKV, (bf16*)X, FC, PTR(7) + L * NREL * 8, gw, NGW, lane, 7u & ~MFMA_MASK); } \
    SEAM(P0 + 3); \
    if (IN(P0 + 4)) { PH_BEGIN const bf16* w = (const bf16*)(ws + WS_WMIX + (size_t)L * WMIX_LAYER + WMIX_BR); \
        pg8::StaticOrder S; S.init(M, DM, G, bx); \
        { pg8::Gemm g{(const bf16*)X, w}; pg8::EpiBranch1 E{GT, MG}; pg8::gemm_phase<pg8::EpiBranch1, pg8::StaticOrder, DM, DM, DM>(lds, g, S, E); } } \
    SEAM(P0 + 4); \
    if (IN(P0 + 5)) { PH_BEGIN \
        if (L == 0) conv_ffn(lds, ws, 0, 1, 1, scr, gw, NGW, lane); \
        else conv_ffn(lds, ws, 1, 1, 0, scr, gw, NGW, lane, 1); \
        __syncthreads(); \
        const bf16* w = (const bf16*)(ws + WS_WMIX + (size_t)L * WMIX_LAYER + WMIX_OUT); \
        pg8::Gemm g{MG, w}; pg8::StaticOrder S; S.init(M, DM, G, bx); pg8::EpiResid E{XN, X, XN, PART, nullptr, nullptr, nullptr, nullptr, nullptr, 1.0f}; \
        pg8::gemm_phase<pg8::EpiResid, pg8::StaticOrder, DM, DM, DM>(lds, g, S, E); } \
    SEAM(P0 + 5); \
    if (IN(P0 + 6)) { PH_BEGIN const bf16* w = (const bf16*)(ws + WS_T + (size_t)(L == 0 ? 1 : 0) * FFN_SLOT); \
        pg8::Gemm g{XN, w}; pg8::StaticOrder S; S.init(M, 2 * DFF, G, bx); pg8::EpiSwiglu E{HB, DFF, PART}; \
        pg8::gemm_phase<pg8::EpiSwiglu, pg8::StaticOrder, DM, DM, DM>(lds, g, S, E); \
        if (L == 0) {     \
            const int nidle = G - (1408 % G); \
            if (1408 % G != 0 && bx >= 1408 % G) conv_ffn(lds, ws, 1, 0, 2, scr, (bx - 1408 % G) * NWAVES + wave, nidle * NWAVES, lane); \
            else if (1408 % G == 0) conv_ffn(lds, ws, 1, 0, 2, scr, gw, NGW, lane); } \
        else {     \
            const int nidle = G - (1408 % G); \
            if (1408 % G != 0 && bx >= 1408 % G) conv_ffn(lds, ws, 1, 1, 0, scr, (bx - 1408 % G) * NWAVES + wave, nidle * NWAVES, lane, 2); \
            else if (1408 % G == 0) conv_ffn(lds, ws, 1, 1, 0, scr, gw, NGW, lane, 2); } } \
    SEAM(P0 + 6); \
    if (IN(P0 + 7)) { PH_BEGIN const bf16* w = (const bf16*)(ws + WS_T + (size_t)(L == 0 ? 1 : 0) * FFN_SLOT + FFN_SLOT_OUT); \
        pg8::Gemm g{HB, w}; pg8::StaticOrder S; S.init(M, DM, G, bx); pg8::EpiResid E{XN, X, L == 1 ? nullptr : XN, PART, nullptr, nullptr, nullptr, L == 1 ? PTR(15) : nullptr, (unsigned*)(ws + WS_CTL) + CW_PANEL, 0.5f}; \
        pg8::gemm_phase<pg8::EpiResid, pg8::StaticOrder, DFF, DFF, DFF>(lds, g, S, E); } \
    SEAM(P0 + 7);

    LAYER(0, 1)
    LAYER(1, 9)
    for (int rep = 0; rep < PROBE_SYNC; ++rep) xcd_barrier(xbar);
}

extern "C" void kernel_launch(void* const* d_in, const int* in_sizes, int n_in, void* d_out, int out_size, void* d_ws, size_t ws_size, hipStream_t stream) {
    static int grid = 0;
    if (grid == 0) {
        if (n_in != 16 || out_size != M * DM || ws_size < WS_END) { fprintf(stderr, "kernel_launch: unexpected shapes (n_in %d out %d ws %zu)\n", n_in, out_size, ws_size); grid = -1; return; }
        int dev = 0, cus = 0, per_cu = 0;
        (void)hipGetDevice(&dev);
        (void)hipDeviceGetAttribute(&cus, hipDeviceAttributeMultiprocessorCount, dev);
        (void)hipFuncSetAttribute((const void*)mk_fwd, hipFuncAttributeMaxDynamicSharedMemorySize, LDS_BYTES);
        (void)hipOccupancyMaxActiveBlocksPerMultiprocessor(&per_cu, (const void*)mk_fwd, NWAVES * 64, LDS_BYTES);
        if (per_cu < 1) per_cu = 1;
        grid = cus * per_cu;
        if (grid > 256) grid = 256;
        (void)hipGetLastError();
    }
    if (grid < 0) return;
    (void)hipMemsetAsync((char*)d_ws + WS_CTL, 0, 64 * 1024, stream);
    Args a{};
    for (int i = 0; i < 16; ++i) a.in[i] = (const float*)d_in[i];
    a.out = (float*)d_out; a.ws = (unsigned char*)d_ws;
#if MULTI_LAUNCH
    for (int ph = 0; ph < N_PHASES; ++ph) { a.ph_lo = ph; a.ph_hi = ph + 1; hipLaunchKernelGGL(mk_fwd, dim3(grid), dim3(NWAVES * 64), LDS_BYTES, stream, a); }
#else
    a.ph_lo = 0; a.ph_hi = N_PHASES;
    void* args[] = {&a};
    hipError_t e = hipLaunchCooperativeKernel((const void*)mk_fwd, dim3(grid), dim3(NWAVES * 64), args, LDS_BYTES, stream);
    if (e != hipSuccess) fprintf(stderr, "cooperative launch failed: %s (grid %d)\n", hipGetErrorString(e), grid);
#endif
}
```
